# Optimizing an MI355X kernel written in HIP

```python
import jax
import jax.numpy as jnp
from jax import lax
import numpy as np

D_MODEL = 1024
BATCH = 8
SEQ = 2048
DEPTH = 1

D_MIX = D_MODEL
D_RWKV = D_MIX // 2
D_HGRN = D_MIX - D_RWKV
RWKV_HEAD = 64
RWKV_HEADS = D_RWKV // RWKV_HEAD
RANK_W = 64
RANK_A = 64
RANK_G = 128
HGRN_HEAD = 128
HGRN_HEADS = D_HGRN // HGRN_HEAD
CHUNK = 64
CONV_W = 4
N_GROUPS = 4
EXPERTS_PER_GROUP = 8
N_EXPERTS = N_GROUPS * EXPERTS_PER_GROUP
TOP_K = 2
D_EXPERT = 512
RMS_EPS = 1e-6
GN_EPS = 64e-5
L2_EPS = 1e-12
D_RWKV_IN = 3 * D_RWKV + RANK_W + RANK_A + RANK_G
D_HGRN_IN = 4 * D_HGRN
D_IN = D_RWKV_IN + D_HGRN_IN

kernel_name = 'hybrid_rwkv7_hgrn2_hmoe'


def rms_norm(x, gain):
    xf = x.astype(jnp.float32)
    y = xf * lax.rsqrt(jnp.mean(xf * xf, axis=-1, keepdims=True) + RMS_EPS)
    return (y * gain.astype(jnp.float32)).astype(x.dtype)


def token_shift(x):
    return jnp.pad(x, ((0, 0), (1, 0), (0, 0)))[:, :-1]


def causal_dwconv(x, w):
    return lax.conv_general_dilated(
        x, w[:, None, :].astype(x.dtype), window_strides=(1,),
        padding=[(CONV_W - 1, 0)], dimension_numbers=('NWC', 'WIO', 'NWC'),
        feature_group_count=x.shape[-1])


def rwkv7_mixer(p, mu, w0, w_up, a0, a_up, g_up, k_k, k_a, r_k, ln_w, ln_b):
    B, S, _ = p.shape
    f32 = jnp.float32
    p = p.astype(f32)
    p = p + mu * (token_shift(p) - p)
    splits = [D_RWKV, 2 * D_RWKV, 3 * D_RWKV, 3 * D_RWKV + RANK_W, 3 * D_RWKV + RANK_W + RANK_A]
    r, k, v, dw, da, dg = jnp.split(p, splits, axis=-1)
    w = -jax.nn.softplus(-(w0 + jnp.tanh(dw) @ w_up)) - 0.5
    decay = jnp.exp(-jnp.exp(w))
    a = jax.nn.sigmoid(a0 + da @ a_up)
    g = jax.nn.sigmoid(dg) @ g_up
    hs = lambda t: t.reshape(B, S, RWKV_HEADS, RWKV_HEAD)
    kk = hs(k * k_k)
    kk = kk / jnp.maximum(jnp.linalg.norm(kk, axis=-1, keepdims=True), L2_EPS)
    k = k * (1.0 + (a - 1.0) * k_a)
    r, k, v, decay, a = hs(r), hs(k), hs(v), hs(decay), hs(a)

    def step(state, inp):
        r_t, w_t, k_t, v_t, kk_t, a_t = inp
        sa = jnp.einsum('bhvk,bhk->bhv', state, -kk_t)
        state = (state * w_t[:, :, None, :]
                 + sa[..., None] * (kk_t * a_t)[:, :, None, :]
                 + v_t[..., None] * k_t[:, :, None, :])
        return state, jnp.einsum('bhvk,bhk->bhv', state, r_t)

    xs = tuple(jnp.moveaxis(t, 1, 0) for t in (r, decay, k, v, kk, a))
    s0 = jnp.zeros((B, RWKV_HEADS, RWKV_HEAD, RWKV_HEAD), f32)
    _, y = lax.scan(step, s0, xs)
    y = jnp.moveaxis(y, 0, 1)
    mean = jnp.mean(y, axis=-1, keepdims=True)
    var = jnp.mean(jnp.square(y - mean), axis=-1, keepdims=True)
    y = ((y - mean) * lax.rsqrt(var + GN_EPS) * ln_w.reshape(RWKV_HEADS, RWKV_HEAD)
         + ln_b.reshape(RWKV_HEADS, RWKV_HEAD))
    y = y + jnp.sum(r * k * r_k, axis=-1, keepdims=True) * v
    return y.reshape(B, S, D_RWKV) * g


def hgrn2_mixer(p, conv_w, lb, norm_g):
    B, S, _ = p.shape
    f32 = jnp.float32
    qfi = causal_dwconv(p[..., :3 * D_HGRN], conv_w).astype(f32)
    q, f, i = jnp.split(qfi, 3, axis=-1)
    g = p[..., 3 * D_HGRN:].astype(f32)
    q = jax.nn.silu(q)
    log_f = jnp.logaddexp(jnp.log(lb), jnp.log1p(-lb) + jax.nn.log_sigmoid(f))
    k = (1.0 - lb) * jax.nn.sigmoid(-f)
    n_chunks = S // CHUNK

    def chunks(t):
        return t.reshape(B, n_chunks, CHUNK, HGRN_HEADS, HGRN_HEAD).transpose(1, 0, 3, 2, 4)

    causal = jnp.tril(jnp.ones((CHUNK, CHUNK), dtype=bool))

    def chunk_step(state, inp):
        q_c, k_c, v_c, lf_c = inp
        b = jnp.cumsum(lf_c, axis=2)
        diff = b[:, :, :, None, :] - b[:, :, None, :, :]
        decay = jnp.exp(jnp.where(causal[:, :, None], diff, -jnp.inf))
        scores = jnp.einsum('bhtk,bhsk,bhtsk->bhts', q_c, k_c, decay)
        o = (jnp.einsum('bhts,bhsv->bhtv', scores, v_c)
             + jnp.einsum('bhtk,bhkv->bhtv', q_c * jnp.exp(b), state))
        b_last = b[:, :, -1:, :]
        state = (jnp.exp(b_last[:, :, 0, :, None]) * state
                 + jnp.einsum('bhsk,bhsv->bhkv', k_c * jnp.exp(b_last - b), v_c))
        return state, o

    s0 = jnp.zeros((B, HGRN_HEADS, HGRN_HEAD, HGRN_HEAD), f32)
    _, o = lax.scan(chunk_step, s0, (chunks(q), chunks(k), chunks(i), chunks(log_f)))
    o = o.transpose(1, 0, 3, 2, 4).reshape(B, S, HGRN_HEADS, HGRN_HEAD)
    o = o * lax.rsqrt(jnp.mean(o * o, axis=-1, keepdims=True) + RMS_EPS) * norm_g.reshape(HGRN_HEADS, HGRN_HEAD)
    return o.reshape(B, S, D_HGRN) * jax.nn.silu(g)


def hier_moe(x, wg, bg, we, be, w_gate, w_up, w_down):
    B, S, D = x.shape
    f32 = jnp.float32
    t = x.reshape(B * S, D)
    gp = jax.nn.softmax((t @ wg + bg).astype(f32), axis=-1)
    g_w, g_idx = lax.top_k(gp, 1)
    el = (t @ we + be).astype(f32).reshape(-1, N_GROUPS, EXPERTS_PER_GROUP)
    el = jnp.take_along_axis(el, g_idx[:, :, None], axis=1)[:, 0]
    e_w, e_idx = lax.top_k(jax.nn.softmax(el, axis=-1), TOP_K)
    e_w = e_w / jnp.sum(e_w, axis=-1, keepdims=True)
    ids = g_idx * EXPERTS_PER_GROUP + e_idx
    gates = jnp.sum(jax.nn.one_hot(ids, N_EXPERTS, dtype=f32) * (g_w * e_w)[..., None], axis=1)
    y = jnp.zeros((B * S, D), f32)
    for e in range(N_EXPERTS):
        h = jax.nn.silu(t @ w_gate[e]) * (t @ w_up[e])
        y = y + gates[:, e:e + 1] * (h @ w_down[e])
    return y.reshape(B, S, D).astype(x.dtype)


def setup_inputs(seed: int = 0) -> dict:
    key = jax.random.key(seed)
    keys = jax.random.split(key, 32)
    counter = [0]

    def nxt():
        k = keys[counter[0]]
        counter[0] += 1
        return k

    def nrm(shape, scale):
        return scale * jax.random.normal(nxt(), shape, jnp.float32)

    L = DEPTH
    return {
        'x': nrm((BATCH, SEQ, D_MODEL), 1.0),
        'norm1_g': 1.0 + nrm((L, D_MODEL), 0.02),
        'w_in': nrm((L, D_MODEL, D_IN), D_MODEL ** -0.5),
        'rwkv_mu': jax.random.uniform(nxt(), (L, D_RWKV_IN), jnp.float32),
        'rwkv_w0': jax.random.uniform(nxt(), (L, D_RWKV), jnp.float32, -6.5, -1.0),
        'rwkv_w_up': nrm((L, RANK_W, D_RWKV), 0.1 * RANK_W ** -0.5),
        'rwkv_a0': nrm((L, D_RWKV), 0.1),
        'rwkv_a_up': nrm((L, RANK_A, D_RWKV), 0.1 * RANK_A ** -0.5),
        'rwkv_g_up': nrm((L, RANK_G, D_RWKV), RANK_G ** -0.5),
        'rwkv_k_k': 0.85 + nrm((L, D_RWKV), 0.02),
        'rwkv_k_a': 1.0 + nrm((L, D_RWKV), 0.02),
        'rwkv_r_k': nrm((L, RWKV_HEADS, RWKV_HEAD), 0.1),
        'rwkv_ln_w': 1.0 + nrm((L, D_RWKV), 0.02),
        'rwkv_ln_b': nrm((L, D_RWKV), 0.02),
        'hgrn_conv_w': nrm((L, CONV_W, 3 * D_HGRN), CONV_W ** -0.5),
        'hgrn_lb_logits': nrm((L + 1, D_HGRN), 0.1),
        'hgrn_norm_g': 1.0 + nrm((L, D_HGRN), 0.02),
        'w_out': nrm((L, D_MIX, D_MODEL), D_MIX ** -0.5),
        'norm2_g': 1.0 + nrm((L, D_MODEL), 0.02),
        'router_g_w': nrm((L, D_MODEL, N_GROUPS), D_MODEL ** -0.5),
        'router_g_b': nrm((L, N_GROUPS), 0.01),
        'router_e_w': nrm((L, D_MODEL, N_EXPERTS), D_MODEL ** -0.5),
        'router_e_b': nrm((L, N_EXPERTS), 0.01),
        'exp_w_gate': nrm((L, N_EXPERTS, D_MODEL, D_EXPERT), D_MODEL ** -0.5),
        'exp_w_up': nrm((L, N_EXPERTS, D_MODEL, D_EXPERT), D_MODEL ** -0.5),
        'exp_w_down': nrm((L, N_EXPERTS, D_EXPERT, D_MODEL), D_EXPERT ** -0.5),
        'final_norm_g': 1.0 + nrm((D_MODEL,), 0.02),
    }


def reference(x, norm1_g, w_in, rwkv_mu, rwkv_w0, rwkv_w_up, rwkv_a0, rwkv_a_up, rwkv_g_up,
              rwkv_k_k, rwkv_k_a, rwkv_r_k, rwkv_ln_w, rwkv_ln_b, hgrn_conv_w, hgrn_lb_logits,
              hgrn_norm_g, w_out, norm2_g, router_g_w, router_g_b, router_e_w, router_e_b,
              exp_w_gate, exp_w_up, exp_w_down, final_norm_g):
    lb_all = jnp.cumsum(jax.nn.softmax(hgrn_lb_logits.astype(jnp.float32), axis=0), axis=0)
    h = x
    for l in range(DEPTH):
        n = rms_norm(h, norm1_g[l])
        p = n @ w_in[l]
        ya = rwkv7_mixer(p[..., :D_RWKV_IN], rwkv_mu[l], rwkv_w0[l], rwkv_w_up[l], rwkv_a0[l],
                         rwkv_a_up[l], rwkv_g_up[l], rwkv_k_k[l], rwkv_k_a[l], rwkv_r_k[l],
                         rwkv_ln_w[l], rwkv_ln_b[l])
        yb = hgrn2_mixer(p[..., D_RWKV_IN:], hgrn_conv_w[l], lb_all[l], hgrn_norm_g[l])
        mix = jnp.concatenate([ya, yb], axis=-1).astype(p.dtype)
        h = h + mix @ w_out[l]
        h = h + hier_moe(rms_norm(h, norm2_g[l]), router_g_w[l], router_g_b[l], router_e_w[l],
                         router_e_b[l], exp_w_gate[l], exp_w_up[l], exp_w_down[l])
    return rms_norm(h, final_norm_g)
```

```cpp
#include <hip/hip_runtime.h>
#include <cstdint>
#include <cstdio>

typedef unsigned short bf16;
#define DEV __device__ __forceinline__
DEV float bf2f(bf16 v) { return __uint_as_float(((unsigned)v) << 16); }
DEV unsigned f2bf(float f) { unsigned u = __float_as_uint(f); return (u + 0x7fffu + ((u >> 16) & 1u)) >> 16; }
DEV unsigned pk2(float lo, float hi) { return f2bf(lo) | (f2bf(hi) << 16); }
DEV float wave_sum(float v) {
#pragma unroll
    for (int o = 1; o < 64; o <<= 1) v += __shfl_xor(v, o);
    return v;
}
DEV float rdlane(float x, int k) { return __uint_as_float(__builtin_amdgcn_readlane(__float_as_uint(x), k)); }
DEV float sigmoidf_(float x) { return 1.0f / (1.0f + __expf(-x)); }

constexpr int BATCH = 8, SEQ = 2048, T = BATCH * SEQ, D = 1024;
constexpr int DR = 512, DH = 512, DRIN = 1792, DHIN = 2048, DIN = 3840;
constexpr int NE = 32, DE = 512;
constexpr float RMS_EPS = 1e-6f, GN_EPS = 64e-5f, L2_EPS = 1e-12f;
constexpr int MAXTILES = 160, MP = MAXTILES * 256;

constexpr size_t MiB = 1u << 20;
constexpr size_t WS_CTL = 0;
constexpr size_t WS_MISC = 64 * 1024;
constexpr size_t WS_WRT = 256 * 1024;
constexpr size_t WS_TOK = 512 * 1024;
constexpr size_t WS_WIN = 1 * MiB;
constexpr size_t WS_WOUT = 9 * MiB;
constexpr size_t WS_WGU = 11 * MiB;
constexpr size_t WS_WD = 75 * MiB;
constexpr size_t WS_XN = 107 * MiB;
constexpr size_t WS_P = 139 * MiB;
constexpr size_t WS_XG = WS_P, WS_H = WS_P + 80 * MiB, WS_YO = WS_P;
constexpr size_t WS_END = 259 * MiB;
constexpr size_t WS_S0 = 11 * MiB, WS_S1 = 43 * MiB, WS_S2 = 75 * MiB;
namespace pg8 {
#define PG8_LAS __attribute__((address_space(3)))
typedef unsigned short bf16_t;
typedef short bf16x8 __attribute__((ext_vector_type(8)));
typedef float f32x4 __attribute__((ext_vector_type(4)));
typedef unsigned u32x4 __attribute__((ext_vector_type(4)));
constexpr int BM = 256, BK = 64, HALF = 128, HTB = HALF * BK * 2  , STAGE_BYTES = 8 * HTB, NXCD = 8, WGM = 8;

__host__ __device__ __forceinline__ int lds_byte(int r, int c) { const int st = (r >> 4) * 2 + (c >> 5), rr = r & 15, cc = c & 31, ob = rr * 64 + cc * 2; return st * 1024 + (ob ^ (((ob >> 9) & 1) << 5)); }
__host__ __device__ __forceinline__ void stage_rc(int b, int& R, int& C) { const int st = b / 1024, sb = b % 1024, swz = sb ^ (((sb >> 9) & 1) << 5); R = (st >> 1) * 16 + swz / 64; C = (st & 1) * 32 + (swz % 64) / 2; }
__host__ __device__ __forceinline__ int perm32(int rho) { const int n = rho >> 4, i = rho & 15; return 8 * (i >> 2) + 4 * n + (i & 3); }

struct Unit { int pm, pn; const char* a; const char* b; };
struct Gemm { int K; };

__device__ __forceinline__ bool order_unit(long L, int nM, int nN, int& pm, int& pn) {
    const int nwg = nM * nN; if (L >= nwg) return false;
    int wgid = (int)L; { const int q = nwg / NXCD, r = nwg % NXCD, xcd = wgid % NXCD, off = wgid / NXCD; wgid = (xcd < r ? xcd * (q + 1) : r * (q + 1) + (xcd - r) * q) + off; }
    const int nig = WGM * nN, gid = wgid / nig, fm = gid * WGM, gsz = (nM - fm) < WGM ? (nM - fm) : WGM;
    pm = fm + ((wgid % nig) % gsz); pn = (wgid % nig) / gsz; return true;
}
struct StaticOrder {
    const char* A; const char* Bt; int nM, nN, G, c; size_t tstep;
    __device__ void init(const void* A_, const void* Bt_, int M, int N, int K, int G_, int c_) { A = (const char*)A_; Bt = (const char*)Bt_; nM = M / BM; nN = N / BM; G = G_; c = c_; tstep = (size_t)BM * K * 2; }
    __device__ bool next(int i, Unit& u) const {
        if (!order_unit((long)i * G + c, nM, nN, u.pm, u.pn)) return false;
        u.a = A + (size_t)u.pm * tstep; u.b = Bt + (size_t)u.pn * tstep; return true;
    }
    __device__ __forceinline__ void a_ready(const Unit&) const {}
    __device__ __forceinline__ void done(const Unit&) const {}
};
struct MoeOrder {
    const char* A; const char* Bt; const int* tile_expert; int nM, nN, G, c; size_t tstep, estep;
    __device__ void init(const void* A_, const void* Bt_, const int* te, int ntiles, int N, int K, int G_, int c_) { A = (const char*)A_; Bt = (const char*)Bt_; tile_expert = te; nM = ntiles; nN = N / BM; G = G_; c = c_; tstep = (size_t)BM * K * 2; estep = (size_t)N * K * 2; }
    __device__ bool next(int i, Unit& u) const {
        if (!order_unit((long)i * G + c, nM, nN, u.pm, u.pn)) return false;
        const int e = __builtin_amdgcn_readfirstlane(tile_expert[u.pm]);
        u.a = A + (size_t)u.pm * tstep; u.b = Bt + (size_t)e * estep + (size_t)u.pn * tstep; return true;
    }
    __device__ __forceinline__ void a_ready(const Unit&) const {}
    __device__ __forceinline__ void done(const Unit&) const {}
};

__device__ __forceinline__ unsigned cvt_pk_bf16(float lo, float hi) { unsigned r; asm volatile("v_cvt_pk_bf16_f32 %0, %1, %2" : "=v"(r) : "v"(lo), "v"(hi)); return r; }

struct EpiBf16 {
    static constexpr bool PERM = true, AFTER_DRAIN = false;
    bf16_t* O; int ldc;
    __device__ __forceinline__ void operator()(const f32x4 (&acc)[2][2][4][2], const Unit& u, int wr, int wc, int fr, int fq) const {
        const int row0 = u.pm * BM + wr * 64 + fr, col0 = u.pn * BM + wc * 32 + 8 * fq;
#pragma unroll
        for (int ai = 0; ai < 2; ++ai)
#pragma unroll
            for (int m = 0; m < 4; ++m) { bf16_t* rowp = O + (size_t)(row0 + ai * HALF + m * 16) * ldc + col0;
#pragma unroll
                for (int bj = 0; bj < 2; ++bj) { const f32x4 v0 = acc[ai][bj][m][0], v1 = acc[ai][bj][m][1];
                    u32x4 w; w.x = cvt_pk_bf16(v0[0], v0[1]); w.y = cvt_pk_bf16(v0[2], v0[3]); w.z = cvt_pk_bf16(v1[0], v1[1]); w.w = cvt_pk_bf16(v1[2], v1[3]);
                    *(u32x4*)(rowp + bj * HALF) = w; } }
    }
};
struct EpiResF32 {
    static constexpr bool PERM = false, AFTER_DRAIN = false;
    const float* base; float* C; int ldc;
    __device__ __forceinline__ void operator()(const f32x4 (&acc)[2][2][4][2], const Unit& u, int wr, int wc, int fr, int fq) const {
        const int row0 = u.pm * BM + wr * 64 + fr, col0 = u.pn * BM + wc * 32 + 4 * fq;
#pragma unroll
        for (int ai = 0; ai < 2; ++ai)
#pragma unroll
            for (int m = 0; m < 4; ++m) { const size_t off = (size_t)(row0 + ai * HALF + m * 16) * ldc + col0;
#pragma unroll
                for (int bj = 0; bj < 2; ++bj)
#pragma unroll
                    for (int n = 0; n < 2; ++n) *(f32x4*)(C + off + bj * HALF + n * 16) = *(const f32x4*)(base + off + bj * HALF + n * 16) + acc[ai][bj][m][n]; }
    }
};
struct EpiSwiGLU {
    static constexpr bool PERM = true, AFTER_DRAIN = false;
    bf16_t* H; int ldh;
    __device__ __forceinline__ void operator()(const f32x4 (&acc)[2][2][4][2], const Unit& u, int wr, int wc, int fr, int fq) const {
        const int row0 = u.pm * BM + wr * 64 + fr, col0 = u.pn * HALF + wc * 32 + 8 * fq;
#pragma unroll
        for (int ai = 0; ai < 2; ++ai)
#pragma unroll
            for (int m = 0; m < 4; ++m) { bf16_t* rowp = H + (size_t)(row0 + ai * HALF + m * 16) * ldh + col0;
                float o[8];
#pragma unroll
                for (int n = 0; n < 2; ++n)
#pragma unroll
                    for (int j = 0; j < 4; ++j) { const float g = acc[ai][0][m][n][j], up = acc[ai][1][m][n][j]; o[n * 4 + j] = g * up * __builtin_amdgcn_rcpf(1.0f + __expf(-g)); }
                u32x4 w; w.x = cvt_pk_bf16(o[0], o[1]); w.y = cvt_pk_bf16(o[2], o[3]); w.z = cvt_pk_bf16(o[4], o[5]); w.w = cvt_pk_bf16(o[6], o[7]);
                *(u32x4*)rowp = w; }
    }
};
template <class Epi, class Sched, bool ALIGN_EPI = false, bool SP2 = false>
__device__ __forceinline__ void gemm_phase(PG8_LAS unsigned char* lds, const Gemm g, const Sched& S, const Epi& E) {
    const int tid = threadIdx.x, wid = __builtin_amdgcn_readfirstlane(tid >> 6), lane = tid & 63, wr = wid >> 2, wc = wid & 3, fr = lane & 15, fq = lane >> 4;
    const int K = g.K, nt = K / BK;
    unsigned voffA[2], voffB[2];
#pragma unroll
    for (int i = 0; i < 2; ++i) { int R, C; stage_rc(tid * 16 + i * 8192, R, C); const int Rb = Epi::PERM ? ((R & ~31) + perm32(R & 31)) : R;
        voffA[i] = (unsigned)(R * K + C) * 2u; voffB[i] = (unsigned)(Rb * K + C) * 2u; }
    const size_t kstep = (size_t)(BK * 2);
    const size_t hstep = (size_t)HALF * K * 2;
    const unsigned ldsw = (unsigned)wid * 1024u;
    const int aoff = lds_byte(wr * 64 + fr, fq * 8), boff = lds_byte(wc * 32 + fr, fq * 8);
#define PG8_SA(b, h) (((b) * 2 + (h)) * HTB)
#define PG8_SB(b, h) ((4 + (b) * 2 + (h)) * HTB)
#define PG8_STAGE(bufoff, gbase, voff) do { _Pragma("unroll") for (int _i = 0; _i < 2; ++_i) \
        __builtin_amdgcn_global_load_lds((const unsigned*)((const char*)(gbase) + (voff)[_i]), (PG8_LAS unsigned*)(lds + (bufoff) + ldsw + _i * 8192), 16, 0, 0); } while (0)
#define PG8_LDA(dst, b, h) do { _Pragma("unroll") for (int m = 0; m < 4; ++m) _Pragma("unroll") for (int k = 0; k < 2; ++k) dst[m][k] = *(const PG8_LAS bf16x8*)(lds + PG8_SA(b, h) + aoff + m * 2048 + k * 1024); } while (0)
#define PG8_LDB(dst, b, h) do { _Pragma("unroll") for (int n = 0; n < 2; ++n) _Pragma("unroll") for (int k = 0; k < 2; ++k) dst[n][k] = *(const PG8_LAS bf16x8*)(lds + PG8_SB(b, h) + boff + n * 2048 + k * 1024); } while (0)
#define PG8_MMA(ai, bj, At, Bt) do { __builtin_amdgcn_s_setprio(1); _Pragma("unroll") for (int m = 0; m < 4; ++m) _Pragma("unroll") for (int n = 0; n < 2; ++n) _Pragma("unroll") for (int k = 0; k < 2; ++k) \
        acc[ai][bj][m][n] = __builtin_amdgcn_mfma_f32_16x16x32_bf16(Bt[n][k], At[m][k], acc[ai][bj][m][n], 0, 0, 0); __builtin_amdgcn_s_setprio(0); } while (0)
#define PG8_WAIT_V(n) asm volatile("s_waitcnt vmcnt(" #n ")" ::: "memory")
#define PG8_WAIT_L(n) asm volatile("s_waitcnt lgkmcnt(" #n ")" ::: "memory")
#define PG8_BAR __builtin_amdgcn_s_barrier()
#define PG8_SCHED __builtin_amdgcn_sched_barrier(0)
    Unit cur, nxt; int ui = 0;
    if (!S.next(0, cur)) return;
    f32x4 acc[2][2][4][2];
#pragma unroll
    for (int a = 0; a < 2; ++a)
#pragma unroll
        for (int b = 0; b < 2; ++b)
#pragma unroll
            for (int m = 0; m < 4; ++m)
#pragma unroll
                for (int n = 0; n < 2; ++n) acc[a][b][m][n] = (f32x4){0.f, 0.f, 0.f, 0.f};
    bf16x8 At[4][2], B0[2][2], B1[2][2];
    const char* cA = cur.a; const char* cB = cur.b;
    S.a_ready(cur);
    if constexpr (SP2) {
        PG8_STAGE(PG8_SB(0, 0), cB, voffB); PG8_STAGE(PG8_SB(0, 1), cB + hstep, voffB); PG8_STAGE(PG8_SA(0, 0), cA, voffA); PG8_STAGE(PG8_SA(0, 1), cA + hstep, voffA);
        if (wr == 1) PG8_BAR;
        PG8_WAIT_V(2); PG8_BAR;
        PG8_STAGE(PG8_SB(1, 0), cB + kstep, voffB); PG8_STAGE(PG8_SA(1, 0), cA + kstep, voffA); PG8_STAGE(PG8_SB(1, 1), cB + hstep + kstep, voffB);
        PG8_WAIT_V(6); PG8_BAR;
    } else {
        PG8_STAGE(PG8_SB(0, 0), cB, voffB); PG8_STAGE(PG8_SA(0, 0), cA, voffA); PG8_STAGE(PG8_SB(0, 1), cB + hstep, voffB); PG8_STAGE(PG8_SA(0, 1), cA + hstep, voffA);
        if (wr == 1) PG8_BAR;
        PG8_WAIT_V(4); PG8_BAR;
        PG8_STAGE(PG8_SB(1, 0), cB + kstep, voffB); PG8_STAGE(PG8_SA(1, 0), cA + kstep, voffA); PG8_STAGE(PG8_SB(1, 1), cB + hstep + kstep, voffB);
        PG8_WAIT_V(6); PG8_BAR;
    }
    for (;;) {
        const bool has_next = S.next(ui + 1, nxt);
        const char* nA = has_next ? nxt.a : cA; const char* nB = has_next ? nxt.b : cB;
        for (int t = 0; t < nt; t += 2) {
            const bool last = (t == nt - 2);
            const char* a1 = cA + (size_t)(t + 1) * kstep;
            const char* a2 = last ? nA : cA + (size_t)(t + 2) * kstep; const char* b2 = last ? nB : cB + (size_t)(t + 2) * kstep;
            const char* a3 = a2 + kstep; const char* b3 = b2 + kstep;
            if (last && has_next) S.a_ready(nxt);
            if constexpr (SP2) {
            PG8_LDB(B0, 0, 0); PG8_LDB(B1, 0, 1); PG8_SCHED; PG8_LDA(At, 0, 0); PG8_STAGE(PG8_SA(1, 1), a1 + hstep, voffA);
            PG8_WAIT_V(8); PG8_WAIT_L(0); PG8_BAR; PG8_MMA(0, 0, At, B0); PG8_MMA(0, 1, At, B1); PG8_BAR; PG8_SCHED;
            PG8_LDA(At, 0, 1); PG8_STAGE(PG8_SB(0, 0), b2, voffB); PG8_STAGE(PG8_SB(0, 1), b2 + hstep, voffB); PG8_STAGE(PG8_SA(0, 0), a2, voffA);
            PG8_WAIT_V(8); PG8_WAIT_L(0); PG8_BAR; PG8_MMA(1, 0, At, B0); PG8_MMA(1, 1, At, B1); PG8_BAR; PG8_SCHED;
            PG8_LDB(B0, 1, 0); PG8_LDB(B1, 1, 1); PG8_SCHED; PG8_LDA(At, 1, 0); PG8_STAGE(PG8_SA(0, 1), a2 + hstep, voffA);
            PG8_WAIT_V(8); PG8_WAIT_L(0); PG8_BAR; PG8_MMA(0, 0, At, B0); PG8_MMA(0, 1, At, B1); PG8_BAR; PG8_SCHED;
            PG8_LDA(At, 1, 1); PG8_STAGE(PG8_SB(1, 0), b3, voffB); PG8_STAGE(PG8_SB(1, 1), b3 + hstep, voffB); PG8_STAGE(PG8_SA(1, 0), a3, voffA);
            PG8_WAIT_V(8); PG8_WAIT_L(0); PG8_BAR; PG8_MMA(1, 0, At, B0); PG8_MMA(1, 1, At, B1); PG8_BAR; PG8_SCHED;
            } else {
            PG8_LDB(B0, 0, 0); PG8_SCHED; PG8_LDA(At, 0, 0); PG8_STAGE(PG8_SA(1, 1), a1 + hstep, voffA);
            PG8_WAIT_L(8); PG8_BAR; PG8_WAIT_L(0); PG8_MMA(0, 0, At, B0); PG8_BAR; PG8_SCHED;
            PG8_LDB(B1, 0, 1); PG8_STAGE(PG8_SB(0, 0), b2, voffB);
            PG8_BAR; PG8_WAIT_L(0); PG8_MMA(0, 1, At, B1); PG8_BAR;
            PG8_LDA(At, 0, 1); PG8_STAGE(PG8_SA(0, 0), a2, voffA);
            PG8_BAR; PG8_WAIT_L(0); PG8_MMA(1, 0, At, B0); PG8_BAR; PG8_SCHED;
            PG8_STAGE(PG8_SB(0, 1), b2 + hstep, voffB);
            PG8_WAIT_V(6); PG8_BAR; PG8_MMA(1, 1, At, B1); PG8_BAR;
            PG8_LDB(B0, 1, 0); PG8_SCHED; PG8_LDA(At, 1, 0); PG8_STAGE(PG8_SA(0, 1), a2 + hstep, voffA);
            PG8_WAIT_L(8); PG8_BAR; PG8_WAIT_L(0); PG8_MMA(0, 0, At, B0); PG8_BAR; PG8_SCHED;
            PG8_LDB(B1, 1, 1); PG8_STAGE(PG8_SB(1, 0), b3, voffB);
            PG8_BAR; PG8_WAIT_L(0); PG8_MMA(0, 1, At, B1); PG8_BAR;
            PG8_LDA(At, 1, 1); PG8_STAGE(PG8_SA(1, 0), a3, voffA);
            PG8_BAR; PG8_WAIT_L(0); PG8_MMA(1, 0, At, B0); PG8_BAR; PG8_SCHED;
            PG8_STAGE(PG8_SB(1, 1), b3 + hstep, voffB);
            PG8_WAIT_V(6); PG8_BAR; PG8_MMA(1, 1, At, B1); PG8_BAR;
            }
        }
        if constexpr (ALIGN_EPI) { if (wr == 0) PG8_BAR; }
        if constexpr (!Epi::AFTER_DRAIN) { E(acc, cur, wr, wc, fr, fq); S.done(cur); }
        if (!has_next) break;
#pragma unroll
        for (int a = 0; a < 2; ++a)
#pragma unroll
            for (int b = 0; b < 2; ++b)
#pragma unroll
                for (int m = 0; m < 4; ++m)
#pragma unroll
                    for (int n = 0; n < 2; ++n) acc[a][b][m][n] = (f32x4){0.f, 0.f, 0.f, 0.f};
        cur = nxt; cA = nA; cB = nB; ++ui;
        if constexpr (ALIGN_EPI) { if (wr == 1) PG8_BAR; }
    }
    PG8_WAIT_V(0);
    if constexpr (!ALIGN_EPI) { if (wr == 0) PG8_BAR; }
    PG8_BAR;
    if constexpr (Epi::AFTER_DRAIN) { E.fused(acc, cur, wr, wc, fr, fq, lds, wid, lane); S.done(cur); }
#undef PG8_SA
#undef PG8_SB
#undef PG8_STAGE
#undef PG8_LDA
#undef PG8_LDB
#undef PG8_MMA
#undef PG8_WAIT_V
#undef PG8_WAIT_L
#undef PG8_BAR
#undef PG8_SCHED
}
}
#define LAS __attribute__((address_space(3)))
typedef unsigned v4u __attribute__((ext_vector_type(4)));
typedef float f32x4 __attribute__((ext_vector_type(4)));

DEV void transpose_item(const float* W, int N, int k0, int n0, bf16* dst, int ldk, float* scr, int lane) {
#pragma unroll 8
    for (int i = 0; i < 32; ++i) { const int kk = 2 * i + (lane >> 5); scr[kk * 33 + (lane & 31)] = W[(size_t)(k0 + kk) * N + n0 + (lane & 31)]; }
    __builtin_amdgcn_s_waitcnt(0xc07f); asm volatile("" ::: "memory");
    const int c = lane & 7;
#pragma unroll
    for (int j = 0; j < 4; ++j) { const int n = (lane >> 3) + 8 * j; const float* s = scr + (8 * c) * 33 + n;
        v4u o; o.x = pk2(s[0 * 33], s[1 * 33]); o.y = pk2(s[2 * 33], s[3 * 33]); o.z = pk2(s[4 * 33], s[5 * 33]); o.w = pk2(s[6 * 33], s[7 * 33]);
        *(v4u*)(dst + (size_t)n * ldk + k0 + 8 * c) = o; }
    __builtin_amdgcn_s_waitcnt(0xc07f); asm volatile("" ::: "memory");
}
__global__ void __launch_bounds__(256) prep1_kernel(const float* w_in, const float* w_out, const float* rgw, const float* rew, bf16* win_t, bf16* wout_t, float* wrt) {
    __shared__ float scr_all[4][64 * 33];
    const int lane = threadIdx.x & 63, wave = threadIdx.x >> 6;
    float* scr = scr_all[wave];
    const int gw = blockIdx.x * 4 + wave, NGW = gridDim.x * 4;
    constexpr int I_IN = (D / 64) * (DIN / 32), I_OUT = (D / 64) * (D / 32);
    for (int it = gw; it < I_IN + I_OUT; it += NGW) {
        if (it < I_IN) { const int nblk = DIN / 32, kb = it / nblk, nb = it % nblk; transpose_item(w_in, DIN, 64 * kb, 32 * nb, win_t + (size_t)(32 * nb) * D, D, scr, lane); }
        else { const int r = it - I_IN, nblk = D / 32, kb = r / nblk, nb = r % nblk; transpose_item(w_out, D, 64 * kb, 32 * nb, wout_t + (size_t)(32 * nb) * D, D, scr, lane); }
    }
    for (int i = blockIdx.x * 256 + threadIdx.x; i < 36 * 1024; i += gridDim.x * 256) { const int e = i >> 10, d = i & 1023; wrt[i] = e < 4 ? rgw[d * 4 + e] : rew[d * 32 + (e - 4)]; }
}
__global__ void __launch_bounds__(256) prep2_kernel(const float* wg, const float* wu, const float* wd, bf16* wgu_t, bf16* wd_t) {
    __shared__ float scr_all[4][64 * 33];
    const int lane = threadIdx.x & 63, wave = threadIdx.x >> 6;
    float* scr = scr_all[wave];
    const int gw = blockIdx.x * 4 + wave, NGW = gridDim.x * 4;
    constexpr int I_G = (D / 64) * (DE / 32), I_D = (DE / 64) * (D / 32), PER_E = 2 * I_G + I_D;
    for (int it = gw; it < NE * PER_E; it += NGW) {
        const int e = it / PER_E; int r = it % PER_E;
        if (r < 2 * I_G) { const int up = r >= I_G; if (up) r -= I_G; const int nblk = DE / 32, kb = r / nblk, nb = r % nblk, n0 = 32 * nb;
            const float* W = (up ? wu : wg) + (size_t)e * D * DE;
            bf16* dst = wgu_t + ((size_t)e * 1024 + (n0 >> 7) * 256 + up * 128 + (n0 & 127)) * D;
            transpose_item(W, DE, 64 * kb, n0, dst, D, scr, lane); }
        else { r -= 2 * I_G; const int nblk = D / 32, kb = r / nblk, nb = r % nblk, n0 = 32 * nb;
            transpose_item(wd + (size_t)e * DE * D, D, 64 * kb, n0, wd_t + ((size_t)e * D + n0) * DE, DE, scr, lane); }
    }
}
__global__ void __launch_bounds__(256) rmsnorm_bf16_kernel(const float* x, const float* g, bf16* out, int rows) {
    const int lane = threadIdx.x & 63, row = blockIdx.x * 4 + (threadIdx.x >> 6);
    if (row >= rows) return;
    const f32x4* xr = (const f32x4*)(x + (size_t)row * D) + lane; const f32x4* gr = (const f32x4*)g + lane;
    f32x4 v[4]; float s = 0.f;
#pragma unroll
    for (int j = 0; j < 4; ++j) { v[j] = xr[64 * j]; s += (v[j].x * v[j].x + v[j].y * v[j].y) + (v[j].z * v[j].z + v[j].w * v[j].w); }
    const float rstd = rsqrtf(wave_sum(s) * (1.f / D) + RMS_EPS);
    unsigned long long* o8 = (unsigned long long*)(out + (size_t)row * D) + lane;
#pragma unroll
    for (int j = 0; j < 4; ++j) { const f32x4 gg = gr[64 * j]; o8[64 * j] = (unsigned long long)pk2(v[j].x * rstd * gg.x, v[j].y * rstd * gg.y) | ((unsigned long long)pk2(v[j].z * rstd * gg.z, v[j].w * rstd * gg.w) << 32); }
}

constexpr int LDS_BYTES = 147456;
__global__ void __launch_bounds__(512, 2) gemm_in_kernel(const bf16* xn, const bf16* win_t, bf16* p) {
    extern __shared__ __attribute__((aligned(16))) unsigned char lds[];
    pg8::Gemm g{D}; pg8::StaticOrder S; S.init(xn, win_t, T, DIN, D, gridDim.x, blockIdx.x);
    pg8::EpiBf16 E{p, DIN};
    pg8::gemm_phase<pg8::EpiBf16, pg8::StaticOrder, true, true>((LAS unsigned char*)lds, g, S, E);
}
__global__ void __launch_bounds__(512, 2) gemm_out_kernel(const bf16* mix, const bf16* wout_t, const float* x, float* h) {
    extern __shared__ __attribute__((aligned(16))) unsigned char lds[];
    pg8::Gemm g{D}; pg8::StaticOrder S; S.init(mix, wout_t, T, D, D, gridDim.x, blockIdx.x);
    pg8::EpiResF32 E{x, h, D};
    pg8::gemm_phase<pg8::EpiResF32, pg8::StaticOrder, true, true>((LAS unsigned char*)lds, g, S, E);
}
__global__ void __launch_bounds__(512, 2) moe_x_kernel(const bf16* xg, const bf16* wgu_t, const int* misc, bf16* H) {
    extern __shared__ __attribute__((aligned(16))) unsigned char lds[];
    const int ntiles = __builtin_amdgcn_readfirstlane(misc[0]);
    pg8::Gemm g{D}; pg8::MoeOrder S; S.init(xg, wgu_t, misc + 64, ntiles, 1024, D, gridDim.x, blockIdx.x);
    pg8::EpiSwiGLU E{H, DE};
    pg8::gemm_phase<pg8::EpiSwiGLU, pg8::MoeOrder, true, true>((LAS unsigned char*)lds, g, S, E);
}
__global__ void __launch_bounds__(512, 2) moe_y_kernel(const bf16* H, const bf16* wd_t, const int* misc, bf16* yo) {
    extern __shared__ __attribute__((aligned(16))) unsigned char lds[];
    const int ntiles = __builtin_amdgcn_readfirstlane(misc[0]);
    pg8::Gemm g{DE}; pg8::MoeOrder S; S.init(H, wd_t, misc + 64, ntiles, D, DE, gridDim.x, blockIdx.x);
    pg8::EpiBf16 E{yo, D};
    pg8::gemm_phase<pg8::EpiBf16, pg8::MoeOrder, true, true>((LAS unsigned char*)lds, g, S, E);
}

__global__ void __launch_bounds__(256) rwkv_pre_kernel(const bf16* p, const float* mu, const float* w0, const float* w_up, const float* a0, const float* a_up, const float* g_up,
                                                       const float* k_k, const float* k_a, float* decay, float* kk, float* bb, float* kp, float* gg) {
    __shared__ float xs[DRIN];
    const int t = blockIdx.x, s = t % SEQ, tid = threadIdx.x;
    for (int c = tid; c < DRIN; c += 256) { const float cur = bf2f(p[(size_t)t * DIN + c]); const float prev = s > 0 ? bf2f(p[(size_t)(t - 1) * DIN + c]) : 0.f; xs[c] = cur + mu[c] * (prev - cur); }
    __syncthreads();
    { const int j = tid; if (j < 64) xs[1536 + j] = tanhf(xs[1536 + j]); else if (j >= 128) xs[1536 + j] = sigmoidf_(xs[1536 + j]); }
    __syncthreads();
    for (int c = tid; c < DR; c += 256) {
        float zw = w0[c], za = a0[c], g = 0.f;
        for (int j = 0; j < 64; ++j) { zw += xs[1536 + j] * w_up[j * DR + c]; za += xs[1600 + j] * a_up[j * DR + c]; }
        for (int j = 0; j < 128; ++j) g += xs[1664 + j] * g_up[j * DR + c];
        const float nz = -zw, sp = fmaxf(nz, 0.f) + log1pf(__expf(-fabsf(nz)));
        const float wlog = -sp - 0.5f, dec = __expf(-__expf(wlog));
        const float a = sigmoidf_(za);
        const float kraw = xs[512 + c], kkp = kraw * k_k[c];
        const float nrm = sqrtf(wave_sum(kkp * kkp));
        const float kkv = kkp / fmaxf(nrm, L2_EPS);
        const size_t o = (size_t)t * DR + c;
        decay[o] = dec; kk[o] = kkv; bb[o] = kkv * a; kp[o] = kraw * (1.f + (a - 1.f) * k_a[c]); gg[o] = g;
    }
}
__global__ void __launch_bounds__(64) rwkv_scan_kernel(const bf16* p, const float* mu, const float* decay, const float* kk, const float* bb, const float* kp, const float* gg,
                                                      const float* r_k, const float* ln_w, const float* ln_b, bf16* mix) {
    const int b = blockIdx.x >> 3, h = blockIdx.x & 7, lane = threadIdx.x, ch = h * 64 + lane;
    float s[64];
#pragma unroll
    for (int k = 0; k < 64; ++k) s[k] = 0.f;
    const float mur = mu[ch], muv = mu[1024 + ch], rk = r_k[ch], lw = ln_w[ch], lb = ln_b[ch];
    size_t t = (size_t)b * SEQ;
    float n_kk = kk[t * DR + ch], n_w = decay[t * DR + ch], n_b = bb[t * DR + ch], n_k = kp[t * DR + ch], n_g = gg[t * DR + ch];
    float n_pr = bf2f(p[t * DIN + ch]), n_pv = bf2f(p[t * DIN + 1024 + ch]);
    float prev_r = 0.f, prev_v = 0.f;
    for (int step = 0; step < SEQ; ++step, ++t) {
        const float kkl = n_kk, wl = n_w, bl = n_b, kl = n_k, gl = n_g, pr = n_pr, pv = n_pv;
        if (step + 1 < SEQ) { const size_t t1 = t + 1; n_kk = kk[t1 * DR + ch]; n_w = decay[t1 * DR + ch]; n_b = bb[t1 * DR + ch]; n_k = kp[t1 * DR + ch]; n_g = gg[t1 * DR + ch];
            n_pr = bf2f(p[t1 * DIN + ch]); n_pv = bf2f(p[t1 * DIN + 1024 + ch]); }
        const float rl = pr + mur * (prev_r - pr), vl = pv + muv * (prev_v - pv);
        prev_r = pr; prev_v = pv;
        float sa0 = 0.f, sa1 = 0.f, sa2 = 0.f, sa3 = 0.f;
#pragma unroll
        for (int k = 0; k < 64; k += 4) { sa0 += s[k] * rdlane(kkl, k); sa1 += s[k + 1] * rdlane(kkl, k + 1); sa2 += s[k + 2] * rdlane(kkl, k + 2); sa3 += s[k + 3] * rdlane(kkl, k + 3); }
        const float sa = -((sa0 + sa1) + (sa2 + sa3));
        float y0 = 0.f, y1 = 0.f, y2 = 0.f, y3 = 0.f;
#pragma unroll
        for (int k = 0; k < 64; k += 4) {
            s[k] = s[k] * rdlane(wl, k) + sa * rdlane(bl, k) + vl * rdlane(kl, k);                 y0 += s[k] * rdlane(rl, k);
            s[k + 1] = s[k + 1] * rdlane(wl, k + 1) + sa * rdlane(bl, k + 1) + vl * rdlane(kl, k + 1); y1 += s[k + 1] * rdlane(rl, k + 1);
            s[k + 2] = s[k + 2] * rdlane(wl, k + 2) + sa * rdlane(bl, k + 2) + vl * rdlane(kl, k + 2); y2 += s[k + 2] * rdlane(rl, k + 2);
            s[k + 3] = s[k + 3] * rdlane(wl, k + 3) + sa * rdlane(bl, k + 3) + vl * rdlane(kl, k + 3); y3 += s[k + 3] * rdlane(rl, k + 3);
        }
        const float y = (y0 + y1) + (y2 + y3);
        const float mean = wave_sum(y) * (1.f / 64.f), d = y - mean, var = wave_sum(d * d) * (1.f / 64.f);
        const float yn = d * rsqrtf(var + GN_EPS) * lw + lb;
        const float bonus = wave_sum(rl * kl * rk);
        mix[t * D + ch] = (bf16)f2bf((yn + bonus * vl) * gl);
    }
}

__global__ void __launch_bounds__(256) hgrn_pre_kernel(const bf16* p, const float* cw, const float* lbl, float* hq, float* hf, float* hv) {
    const int t = blockIdx.x, s = t % SEQ;
    for (int c = threadIdx.x; c < DH; c += 256) {
        float xq = 0.f, xf = 0.f, xi = 0.f;
#pragma unroll
        for (int j = 0; j < 4; ++j) { const int sp = s - 3 + j; if (sp >= 0) { const bf16* row = p + (size_t)(t - 3 + j) * DIN + DRIN;
            xq += cw[j * 1536 + c] * bf2f(row[c]); xf += cw[j * 1536 + 512 + c] * bf2f(row[512 + c]); xi += cw[j * 1536 + 1024 + c] * bf2f(row[1024 + c]); } }
        const float lb = 1.f / (1.f + __expf(lbl[512 + c] - lbl[c]));
        const size_t o = (size_t)t * DH + c;
        hq[o] = xq * sigmoidf_(xq); hf[o] = lb + (1.f - lb) * sigmoidf_(xf); hv[o] = xi;
    }
}
__global__ void __launch_bounds__(128) hgrn_scan_kernel(const float* hq, const float* hf, const float* hv, float* op0, float* op1) {
    const int half = blockIdx.x & 1, h = (blockIdx.x >> 1) & 3, b = blockIdx.x >> 3, tid = threadIdx.x, lane = tid & 63;
    float* op = half ? op1 : op0;
    float s[64];
#pragma unroll
    for (int k = 0; k < 64; ++k) s[k] = 0.f;
    size_t t = (size_t)b * SEQ;
    const int kc = h * 128 + half * 64 + lane, vc = h * 128 + tid;
    float n_q = hq[t * DH + kc], n_f = hf[t * DH + kc], n_v = hv[t * DH + vc];
    for (int step = 0; step < SEQ; ++step, ++t) {
        const float ql = n_q, fl = n_f, vl = n_v, khl = 1.f - fl;
        if (step + 1 < SEQ) { n_q = hq[(t + 1) * DH + kc]; n_f = hf[(t + 1) * DH + kc]; n_v = hv[(t + 1) * DH + vc]; }
        float o0 = 0.f, o1 = 0.f, o2 = 0.f, o3 = 0.f;
#pragma unroll
        for (int k = 0; k < 64; k += 4) {
            s[k] = s[k] * rdlane(fl, k) + rdlane(khl, k) * vl;                 o0 += rdlane(ql, k) * s[k];
            s[k + 1] = s[k + 1] * rdlane(fl, k + 1) + rdlane(khl, k + 1) * vl; o1 += rdlane(ql, k + 1) * s[k + 1];
            s[k + 2] = s[k + 2] * rdlane(fl, k + 2) + rdlane(khl, k + 2) * vl; o2 += rdlane(ql, k + 2) * s[k + 2];
            s[k + 3] = s[k + 3] * rdlane(fl, k + 3) + rdlane(khl, k + 3) * vl; o3 += rdlane(ql, k + 3) * s[k + 3];
        }
        op[t * DH + vc] = (o0 + o1) + (o2 + o3);
    }
}
__global__ void __launch_bounds__(512) hgrn_post_kernel(const bf16* p, const float* op0, const float* op1, const float* ng, bf16* mix) {
    __shared__ float red[8];
    const int t = blockIdx.x, c = threadIdx.x, wave = c >> 6;
    const float o = op0[(size_t)t * DH + c] + op1[(size_t)t * DH + c];
    const float ws = wave_sum(o * o);
    if ((c & 63) == 0) red[wave] = ws;
    __syncthreads();
    const float ms = (red[(wave & ~1)] + red[(wave | 1)]) * (1.f / 128.f);
    const float g = bf2f(p[(size_t)t * DIN + DRIN + 1536 + c]);
    mix[(size_t)t * D + 512 + c] = (bf16)f2bf(o * rsqrtf(ms + RMS_EPS) * ng[c] * (g * sigmoidf_(g)));
}
__global__ void __launch_bounds__(256) norm2_router_kernel(const float* h, const float* g2, const float* wrt, const float* bg, const float* be, bf16* hn,
                                                           unsigned* cnt, int* tok_e, int* tok_pos, float* tok_gate) {
    const int lane = threadIdx.x & 63, t = blockIdx.x * 4 + (threadIdx.x >> 6);
    const f32x4* xr = (const f32x4*)(h + (size_t)t * D) + lane; const f32x4* gr = (const f32x4*)g2 + lane;
    f32x4 v[4]; float s = 0.f;
#pragma unroll
    for (int j = 0; j < 4; ++j) { v[j] = xr[64 * j]; s += (v[j].x * v[j].x + v[j].y * v[j].y) + (v[j].z * v[j].z + v[j].w * v[j].w); }
    const float rstd = rsqrtf(wave_sum(s) * (1.f / D) + RMS_EPS);
    unsigned long long* o8 = (unsigned long long*)(hn + (size_t)t * D) + lane;
#pragma unroll
    for (int j = 0; j < 4; ++j) { v[j] = v[j] * rstd * gr[64 * j]; o8[64 * j] = (unsigned long long)pk2(v[j].x, v[j].y) | ((unsigned long long)pk2(v[j].z, v[j].w) << 32); }
    float L[36];
#pragma unroll
    for (int e = 0; e < 36; ++e) { const f32x4* wr = (const f32x4*)(wrt + e * D) + lane; float a = 0.f;
#pragma unroll
        for (int j = 0; j < 4; ++j) { const f32x4 w = wr[64 * j]; a += (v[j].x * w.x + v[j].y * w.y) + (v[j].z * w.z + v[j].w * w.w); }
        L[e] = wave_sum(a); }
    float gl[4]; float gm = -1e30f; int gi = 0;
#pragma unroll
    for (int g = 0; g < 4; ++g) { gl[g] = L[g] + bg[g]; if (gl[g] > gm) { gm = gl[g]; gi = g; } }
    float gs = 0.f;
#pragma unroll
    for (int g = 0; g < 4; ++g) gs += __expf(gl[g] - gm);
    const float g_w = 1.f / gs;
    float el[8];
#pragma unroll
    for (int j = 0; j < 8; ++j) el[j] = 0.f;
#pragma unroll
    for (int g = 0; g < 4; ++g) if (g == gi) {
#pragma unroll
        for (int j = 0; j < 8; ++j) el[j] = L[4 + 8 * g + j] + be[8 * g + j]; }
    float m1 = -1e30f; int i1 = 0;
#pragma unroll
    for (int j = 0; j < 8; ++j) if (el[j] > m1) { m1 = el[j]; i1 = j; }
    float m2 = -1e30f; int i2 = 0;
#pragma unroll
    for (int j = 0; j < 8; ++j) if (j != i1 && el[j] > m2) { m2 = el[j]; i2 = j; }
    const float p2 = __expf(m2 - m1), w1 = 1.f / (1.f + p2), w2 = p2 / (1.f + p2);
    if (lane == 0) {
        const int e1 = gi * 8 + i1, e2 = gi * 8 + i2;
        const unsigned q1 = atomicAdd(cnt + e1, 1u), q2 = atomicAdd(cnt + e2, 1u);
        tok_e[2 * t] = e1; tok_e[2 * t + 1] = e2; tok_pos[2 * t] = (int)q1; tok_pos[2 * t + 1] = (int)q2; tok_gate[2 * t] = g_w * w1; tok_gate[2 * t + 1] = g_w * w2;
    }
}
__global__ void moe_offsets_kernel(const unsigned* cnt, int* misc) {
    if (threadIdx.x == 0) { int off = 0, nt = 0;
        for (int e = 0; e < NE; ++e) { const int c = (int)cnt[e], tiles = (c + 255) >> 8; misc[16 + e] = off; for (int i = 0; i < tiles; ++i) misc[64 + nt + i] = e; nt += tiles; off += tiles * 256; }
        misc[0] = nt; }
}
__global__ void __launch_bounds__(256) moe_scatter_kernel(const bf16* hn, const int* tok_e, const int* tok_pos, const int* misc, bf16* xg, int* tok_slot) {
    const int lane = threadIdx.x & 63, t = blockIdx.x * 4 + (threadIdx.x >> 6);
    const v4u* src = (const v4u*)(hn + (size_t)t * D) + lane;
    const v4u a = src[0], b = src[64];
#pragma unroll
    for (int k = 0; k < 2; ++k) { const int e = tok_e[2 * t + k], slot = misc[16 + e] + tok_pos[2 * t + k];
        v4u* dst = (v4u*)(xg + (size_t)slot * D) + lane; dst[0] = a; dst[64] = b;
        if (lane == 0) tok_slot[2 * t + k] = slot; }
}
__global__ void __launch_bounds__(256) final_kernel(float* h, const bf16* yo, const int* tok_slot, const float* tok_gate, const float* gf) {
    const int lane = threadIdx.x & 63, t = blockIdx.x * 4 + (threadIdx.x >> 6);
    f32x4* xr = (f32x4*)(h + (size_t)t * D) + lane; const f32x4* gr = (const f32x4*)gf + lane;
    const int s1 = tok_slot[2 * t], s2 = tok_slot[2 * t + 1]; const float g1 = tok_gate[2 * t], g2 = tok_gate[2 * t + 1];
    const unsigned long long* y1 = (const unsigned long long*)(yo + (size_t)s1 * D) + lane; const unsigned long long* y2 = (const unsigned long long*)(yo + (size_t)s2 * D) + lane;
    f32x4 v[4]; float s = 0.f;
#pragma unroll
    for (int j = 0; j < 4; ++j) { v[j] = xr[64 * j]; const unsigned long long a = y1[64 * j], b = y2[64 * j];
        v[j].x += g1 * bf2f((bf16)(a & 0xffff)) + g2 * bf2f((bf16)(b & 0xffff));
        v[j].y += g1 * bf2f((bf16)((a >> 16) & 0xffff)) + g2 * bf2f((bf16)((b >> 16) & 0xffff));
        v[j].z += g1 * bf2f((bf16)((a >> 32) & 0xffff)) + g2 * bf2f((bf16)((b >> 32) & 0xffff));
        v[j].w += g1 * bf2f((bf16)(a >> 48)) + g2 * bf2f((bf16)(b >> 48));
        s += (v[j].x * v[j].x + v[j].y * v[j].y) + (v[j].z * v[j].z + v[j].w * v[j].w); }
    const float rstd = rsqrtf(wave_sum(s) * (1.f / D) + RMS_EPS);
#pragma unroll
    for (int j = 0; j < 4; ++j) xr[64 * j] = v[j] * rstd * gr[64 * j];
}

extern "C" void kernel_launch(void* const* d_in, const int* in_sizes, int n_in, void* d_out, int out_size, void* d_ws, size_t ws_size, hipStream_t stream) {
    static int ready = 0;
    if (ready == 0) {
        if (n_in != 27 || in_sizes[0] != T * D || out_size != T * D || ws_size < WS_END) { fprintf(stderr, "kernel_launch: unexpected shapes (n_in %d, in0 %d, out %d, ws %zu)\n", n_in, n_in > 0 ? in_sizes[0] : -1, out_size, ws_size); ready = -1; return; }
        hipFuncSetAttribute((const void*)gemm_in_kernel, hipFuncAttributeMaxDynamicSharedMemorySize, LDS_BYTES);
        hipFuncSetAttribute((const void*)gemm_out_kernel, hipFuncAttributeMaxDynamicSharedMemorySize, LDS_BYTES);
        hipFuncSetAttribute((const void*)moe_x_kernel, hipFuncAttributeMaxDynamicSharedMemorySize, LDS_BYTES);
        hipFuncSetAttribute((const void*)moe_y_kernel, hipFuncAttributeMaxDynamicSharedMemorySize, LDS_BYTES);
        ready = 1;
    }
    if (ready < 0) return;
    const float* const* in = (const float* const*)d_in;
    unsigned char* ws = (unsigned char*)d_ws; float* out = (float*)d_out;
    bf16 *win_t = (bf16*)(ws + WS_WIN), *wout_t = (bf16*)(ws + WS_WOUT), *wgu_t = (bf16*)(ws + WS_WGU), *wd_t = (bf16*)(ws + WS_WD);
    bf16 *xn = (bf16*)(ws + WS_XN), *p = (bf16*)(ws + WS_P), *xg = (bf16*)(ws + WS_XG), *H = (bf16*)(ws + WS_H), *yo = (bf16*)(ws + WS_YO);
    float* wrt = (float*)(ws + WS_WRT); unsigned* cnt = (unsigned*)(ws + WS_CTL); int* misc = (int*)(ws + WS_MISC);
    int* tok_e = (int*)(ws + WS_TOK); int* tok_pos = tok_e + 2 * T; float* tok_gate = (float*)(tok_pos + 2 * T); int* tok_slot = (int*)(tok_gate + 2 * T);
    float *S0 = (float*)(ws + WS_S0), *S1 = (float*)(ws + WS_S1), *S2 = (float*)(ws + WS_S2), *S3 = out, *S4 = out + (size_t)T * 512;
    hipMemsetAsync(ws + WS_CTL, 0, 4096, stream);
    prep1_kernel<<<512, 256, 0, stream>>>(in[2], in[17], in[19], in[21], win_t, wout_t, wrt);
    rmsnorm_bf16_kernel<<<T / 4, 256, 0, stream>>>(in[0], in[1], xn, T);
    gemm_in_kernel<<<256, 512, LDS_BYTES, stream>>>(xn, win_t, p);
    rwkv_pre_kernel<<<T, 256, 0, stream>>>(p, in[3], in[4], in[5], in[6], in[7], in[8], in[9], in[10], S0, S1, S2, S3, S4);
    rwkv_scan_kernel<<<64, 64, 0, stream>>>(p, in[3], S0, S1, S2, S3, S4, in[11], in[12], in[13], xn  );
    hgrn_pre_kernel<<<T, 256, 0, stream>>>(p, in[14], in[15], S0, S1, S2);
    hgrn_scan_kernel<<<64, 128, 0, stream>>>(S0, S1, S2, S3, S4);
    hgrn_post_kernel<<<T, 512, 0, stream>>>(p, S3, S4, in[16], xn  );
    prep2_kernel<<<1024, 256, 0, stream>>>(in[23], in[24], in[25], wgu_t, wd_t);
    gemm_out_kernel<<<256, 512, LDS_BYTES, stream>>>(xn  , wout_t, in[0], out  );
    norm2_router_kernel<<<T / 4, 256, 0, stream>>>(out, in[18], wrt, in[20], in[22], xn  , cnt, tok_e, tok_pos, tok_gate);
    moe_offsets_kernel<<<1, 64, 0, stream>>>(cnt, misc);
    moe_scatter_kernel<<<T / 4, 256, 0, stream>>>(xn, tok_e, tok_pos, misc, xg, tok_slot);
    moe_x_kernel<<<256, 512, LDS_BYTES, stream>>>(xg, wgu_t, misc, H);
    moe_y_kernel<<<256, 512, LDS_BYTES, stream>>>(H, wd_t, misc, yo);
    final_kernel<<<T / 4, 256, 0, stream>>>(out, yo, tok_slot, tok_gate, in[26]);
}
```

```cpp
#include <hip/hip_runtime.h>
#include <cstdint>
#include <cstdio>

typedef unsigned short bf16;
#define DEV __device__ __forceinline__
DEV float bf2f(bf16 v) { return __uint_as_float(((unsigned)v) << 16); }
DEV unsigned f2bf(float f) { unsigned u = __float_as_uint(f); return (u + 0x7fffu + ((u >> 16) & 1u)) >> 16; }
DEV unsigned pk2(float lo, float hi) { return f2bf(lo) | (f2bf(hi) << 16); }
DEV float wave_sum(float v) {
#pragma unroll
    for (int o = 1; o < 64; o <<= 1) v += __shfl_xor(v, o);
    return v;
}
DEV float rdlane(float x, int k) { return __uint_as_float(__builtin_amdgcn_readlane(__float_as_uint(x), k)); }
DEV float sigmoidf_(float x) { return 1.0f / (1.0f + __expf(-x)); }

constexpr int BATCH = 8, SEQ = 2048, T = BATCH * SEQ, D = 1024;
constexpr int DR = 512, DH = 512, DRIN = 1792, DHIN = 2048, DIN = 3840;
constexpr int NE = 32, DE = 512;
constexpr float RMS_EPS = 1e-6f, GN_EPS = 64e-5f, L2_EPS = 1e-12f;
constexpr int MAXTILES = 160, MP = MAXTILES * 256;

constexpr size_t MiB = 1u << 20;
constexpr size_t WS_CTL = 0;
constexpr size_t WS_MISC = 64 * 1024;
constexpr size_t WS_WRT = 256 * 1024;
constexpr size_t WS_TOK = 512 * 1024;
constexpr size_t WS_WIN = 1 * MiB;
constexpr size_t WS_WOUT = 9 * MiB;
constexpr size_t WS_WGU = 11 * MiB;
constexpr size_t WS_WD = 75 * MiB;
constexpr size_t WS_XN = 107 * MiB;
constexpr size_t WS_P = 139 * MiB;
constexpr size_t WS_XG = WS_P, WS_H = WS_P + 80 * MiB, WS_YO = WS_P;
constexpr size_t WS_END = 259 * MiB;
constexpr size_t WS_S0 = 11 * MiB, WS_S1 = 43 * MiB, WS_S2 = 75 * MiB;
namespace pg8 {
#define PG8_LAS __attribute__((address_space(3)))
typedef unsigned short bf16_t;
typedef short bf16x8 __attribute__((ext_vector_type(8)));
typedef float f32x4 __attribute__((ext_vector_type(4)));
typedef unsigned u32x4 __attribute__((ext_vector_type(4)));
constexpr int BM = 256, BK = 64, HALF = 128, HTB = HALF * BK * 2  , STAGE_BYTES = 8 * HTB, NXCD = 8, WGM = 8;

__host__ __device__ __forceinline__ int lds_byte(int r, int c) { const int st = (r >> 4) * 2 + (c >> 5), rr = r & 15, cc = c & 31, ob = rr * 64 + cc * 2; return st * 1024 + (ob ^ (((ob >> 9) & 1) << 5)); }
__host__ __device__ __forceinline__ void stage_rc(int b, int& R, int& C) { const int st = b / 1024, sb = b % 1024, swz = sb ^ (((sb >> 9) & 1) << 5); R = (st >> 1) * 16 + swz / 64; C = (st & 1) * 32 + (swz % 64) / 2; }
__host__ __device__ __forceinline__ int perm32(int rho) { const int n = rho >> 4, i = rho & 15; return 8 * (i >> 2) + 4 * n + (i & 3); }

struct Unit { int pm, pn; const char* a; const char* b; };
struct Gemm { int K; };

__device__ __forceinline__ bool order_unit(long L, int nM, int nN, int& pm, int& pn) {
    const int nwg = nM * nN; if (L >= nwg) return false;
    int wgid = (int)L; { const int q = nwg / NXCD, r = nwg % NXCD, xcd = wgid % NXCD, off = wgid / NXCD; wgid = (xcd < r ? xcd * (q + 1) : r * (q + 1) + (xcd - r) * q) + off; }
    const int nig = WGM * nN, gid = wgid / nig, fm = gid * WGM, gsz = (nM - fm) < WGM ? (nM - fm) : WGM;
    pm = fm + ((wgid % nig) % gsz); pn = (wgid % nig) / gsz; return true;
}
struct StaticOrder {
    const char* A; const char* Bt; int nM, nN, G, c; size_t tstep;
    __device__ void init(const void* A_, const void* Bt_, int M, int N, int K, int G_, int c_) { A = (const char*)A_; Bt = (const char*)Bt_; nM = M / BM; nN = N / BM; G = G_; c = c_; tstep = (size_t)BM * K * 2; }
    __device__ bool next(int i, Unit& u) const {
        if (!order_unit((long)i * G + c, nM, nN, u.pm, u.pn)) return false;
        u.a = A + (size_t)u.pm * tstep; u.b = Bt + (size_t)u.pn * tstep; return true;
    }
    __device__ __forceinline__ void a_ready(const Unit&) const {}
    __device__ __forceinline__ void done(const Unit&) const {}
};
struct MoeOrder {
    const char* A; const char* Bt; const int* tile_expert; int nM, nN, G, c; size_t tstep, estep;
    __device__ void init(const void* A_, const void* Bt_, const int* te, int ntiles, int N, int K, int G_, int c_) { A = (const char*)A_; Bt = (const char*)Bt_; tile_expert = te; nM = ntiles; nN = N / BM; G = G_; c = c_; tstep = (size_t)BM * K * 2; estep = (size_t)N * K * 2; }
    __device__ bool next(int i, Unit& u) const {
        if (!order_unit((long)i * G + c, nM, nN, u.pm, u.pn)) return false;
        const int e = __builtin_amdgcn_readfirstlane(tile_expert[u.pm]);
        u.a = A + (size_t)u.pm * tstep; u.b = Bt + (size_t)e * estep + (size_t)u.pn * tstep; return true;
    }
    __device__ __forceinline__ void a_ready(const Unit&) const {}
    __device__ __forceinline__ void done(const Unit&) const {}
};

__device__ __forceinline__ unsigned cvt_pk_bf16(float lo, float hi) { unsigned r; asm volatile("v_cvt_pk_bf16_f32 %0, %1, %2" : "=v"(r) : "v"(lo), "v"(hi)); return r; }

struct EpiBf16 {
    static constexpr bool PERM = true, AFTER_DRAIN = false;
    bf16_t* O; int ldc;
    __device__ __forceinline__ void operator()(const f32x4 (&acc)[2][2][4][2], const Unit& u, int wr, int wc, int fr, int fq) const {
        const int row0 = u.pm * BM + wr * 64 + fr, col0 = u.pn * BM + wc * 32 + 8 * fq;
#pragma unroll
        for (int ai = 0; ai < 2; ++ai)
#pragma unroll
            for (int m = 0; m < 4; ++m) { bf16_t* rowp = O + (size_t)(row0 + ai * HALF + m * 16) * ldc + col0;
#pragma unroll
                for (int bj = 0; bj < 2; ++bj) { const f32x4 v0 = acc[ai][bj][m][0], v1 = acc[ai][bj][m][1];
                    u32x4 w; w.x = cvt_pk_bf16(v0[0], v0[1]); w.y = cvt_pk_bf16(v0[2], v0[3]); w.z = cvt_pk_bf16(v1[0], v1[1]); w.w = cvt_pk_bf16(v1[2], v1[3]);
                    *(u32x4*)(rowp + bj * HALF) = w; } }
    }
};
struct EpiResF32 {
    static constexpr bool PERM = false, AFTER_DRAIN = false;
    const float* base; float* C; int ldc;
    __device__ __forceinline__ void operator()(const f32x4 (&acc)[2][2][4][2], const Unit& u, int wr, int wc, int fr, int fq) const {
        const int row0 = u.pm * BM + wr * 64 + fr, col0 = u.pn * BM + wc * 32 + 4 * fq;
#pragma unroll
        for (int ai = 0; ai < 2; ++ai)
#pragma unroll
            for (int m = 0; m < 4; ++m) { const size_t off = (size_t)(row0 + ai * HALF + m * 16) * ldc + col0;
#pragma unroll
                for (int bj = 0; bj < 2; ++bj)
#pragma unroll
                    for (int n = 0; n < 2; ++n) *(f32x4*)(C + off + bj * HALF + n * 16) = *(const f32x4*)(base + off + bj * HALF + n * 16) + acc[ai][bj][m][n]; }
    }
};
struct EpiSwiGLU {
    static constexpr bool PERM = true, AFTER_DRAIN = false;
    bf16_t* H; int ldh;
    __device__ __forceinline__ void operator()(const f32x4 (&acc)[2][2][4][2], const Unit& u, int wr, int wc, int fr, int fq) const {
        const int row0 = u.pm * BM + wr * 64 + fr, col0 = u.pn * HALF + wc * 32 + 8 * fq;
#pragma unroll
        for (int ai = 0; ai < 2; ++ai)
#pragma unroll
            for (int m = 0; m < 4; ++m) { bf16_t* rowp = H + (size_t)(row0 + ai * HALF + m * 16) * ldh + col0;
                float o[8];
#pragma unroll
                for (int n = 0; n < 2; ++n)
#pragma unroll
                    for (int j = 0; j < 4; ++j) { const float g = acc[ai][0][m][n][j], up = acc[ai][1][m][n][j]; o[n * 4 + j] = g * up * __builtin_amdgcn_rcpf(1.0f + __expf(-g)); }
                u32x4 w; w.x = cvt_pk_bf16(o[0], o[1]); w.y = cvt_pk_bf16(o[2], o[3]); w.z = cvt_pk_bf16(o[4], o[5]); w.w = cvt_pk_bf16(o[6], o[7]);
                *(u32x4*)rowp = w; }
    }
};
template <class Epi, class Sched, bool ALIGN_EPI = false, bool SP2 = false>
__device__ __forceinline__ void gemm_phase(PG8_LAS unsigned char* lds, const Gemm g, const Sched& S, const Epi& E) {
    const int tid = threadIdx.x, wid = __builtin_amdgcn_readfirstlane(tid >> 6), lane = tid & 63, wr = wid >> 2, wc = wid & 3, fr = lane & 15, fq = lane >> 4;
    const int K = g.K, nt = K / BK;
    unsigned voffA[2], voffB[2];
#pragma unroll
    for (int i = 0; i < 2; ++i) { int R, C; stage_rc(tid * 16 + i * 8192, R, C); const int Rb = Epi::PERM ? ((R & ~31) + perm32(R & 31)) : R;
        voffA[i] = (unsigned)(R * K + C) * 2u; voffB[i] = (unsigned)(Rb * K + C) * 2u; }
    const size_t kstep = (size_t)(BK * 2);
    const size_t hstep = (size_t)HALF * K * 2;
    const unsigned ldsw = (unsigned)wid * 1024u;
    const int aoff = lds_byte(wr * 64 + fr, fq * 8), boff = lds_byte(wc * 32 + fr, fq * 8);
#define PG8_SA(b, h) (((b) * 2 + (h)) * HTB)
#define PG8_SB(b, h) ((4 + (b) * 2 + (h)) * HTB)
#define PG8_STAGE(bufoff, gbase, voff) do { _Pragma("unroll") for (int _i = 0; _i < 2; ++_i) \
        __builtin_amdgcn_global_load_lds((const unsigned*)((const char*)(gbase) + (voff)[_i]), (PG8_LAS unsigned*)(lds + (bufoff) + ldsw + _i * 8192), 16, 0, 0); } while (0)
#define PG8_LDA(dst, b, h) do { _Pragma("unroll") for (int m = 0; m < 4; ++m) _Pragma("unroll") for (int k = 0; k < 2; ++k) dst[m][k] = *(const PG8_LAS bf16x8*)(lds + PG8_SA(b, h) + aoff + m * 2048 + k * 1024); } while (0)
#define PG8_LDB(dst, b, h) do { _Pragma("unroll") for (int n = 0; n < 2; ++n) _Pragma("unroll") for (int k = 0; k < 2; ++k) dst[n][k] = *(const PG8_LAS bf16x8*)(lds + PG8_SB(b, h) + boff + n * 2048 + k * 1024); } while (0)
#define PG8_MMA(ai, bj, At, Bt) do { __builtin_amdgcn_s_setprio(1); _Pragma("unroll") for (int m = 0; m < 4; ++m) _Pragma("unroll") for (int n = 0; n < 2; ++n) _Pragma("unroll") for (int k = 0; k < 2; ++k) \
        acc[ai][bj][m][n] = __builtin_amdgcn_mfma_f32_16x16x32_bf16(Bt[n][k], At[m][k], acc[ai][bj][m][n], 0, 0, 0); __builtin_amdgcn_s_setprio(0); } while (0)
#define PG8_WAIT_V(n) asm volatile("s_waitcnt vmcnt(" #n ")" ::: "memory")
#define PG8_WAIT_L(n) asm volatile("s_waitcnt lgkmcnt(" #n ")" ::: "memory")
#define PG8_BAR __builtin_amdgcn_s_barrier()
#define PG8_SCHED __builtin_amdgcn_sched_barrier(0)
    Unit cur, nxt; int ui = 0;
    if (!S.next(0, cur)) return;
    f32x4 acc[2][2][4][2];
#pragma unroll
    for (int a = 0; a < 2; ++a)
#pragma unroll
        for (int b = 0; b < 2; ++b)
#pragma unroll
            for (int m = 0; m < 4; ++m)
#pragma unroll
                for (int n = 0; n < 2; ++n) acc[a][b][m][n] = (f32x4){0.f, 0.f, 0.f, 0.f};
    bf16x8 At[4][2], B0[2][2], B1[2][2];
    const char* cA = cur.a; const char* cB = cur.b;
    S.a_ready(cur);
    if constexpr (SP2) {
        PG8_STAGE(PG8_SB(0, 0), cB, voffB); PG8_STAGE(PG8_SB(0, 1), cB + hstep, voffB); PG8_STAGE(PG8_SA(0, 0), cA, voffA); PG8_STAGE(PG8_SA(0, 1), cA + hstep, voffA);
        if (wr == 1) PG8_BAR;
        PG8_WAIT_V(2); PG8_BAR;
        PG8_STAGE(PG8_SB(1, 0), cB + kstep, voffB); PG8_STAGE(PG8_SA(1, 0), cA + kstep, voffA); PG8_STAGE(PG8_SB(1, 1), cB + hstep + kstep, voffB);
        PG8_WAIT_V(6); PG8_BAR;
    } else {
        PG8_STAGE(PG8_SB(0, 0), cB, voffB); PG8_STAGE(PG8_SA(0, 0), cA, voffA); PG8_STAGE(PG8_SB(0, 1), cB + hstep, voffB); PG8_STAGE(PG8_SA(0, 1), cA + hstep, voffA);
        if (wr == 1) PG8_BAR;
        PG8_WAIT_V(4); PG8_BAR;
        PG8_STAGE(PG8_SB(1, 0), cB + kstep, voffB); PG8_STAGE(PG8_SA(1, 0), cA + kstep, voffA); PG8_STAGE(PG8_SB(1, 1), cB + hstep + kstep, voffB);
        PG8_WAIT_V(6); PG8_BAR;
    }
    for (;;) {
        const bool has_next = S.next(ui + 1, nxt);
        const char* nA = has_next ? nxt.a : cA; const char* nB = has_next ? nxt.b : cB;
        for (int t = 0; t < nt; t += 2) {
            const bool last = (t == nt - 2);
            const char* a1 = cA + (size_t)(t + 1) * kstep;
            const char* a2 = last ? nA : cA + (size_t)(t + 2) * kstep; const char* b2 = last ? nB : cB + (size_t)(t + 2) * kstep;
            const char* a3 = a2 + kstep; const char* b3 = b2 + kstep;
            if (last && has_next) S.a_ready(nxt);
            if constexpr (SP2) {
            PG8_LDB(B0, 0, 0); PG8_LDB(B1, 0, 1); PG8_SCHED; PG8_LDA(At, 0, 0); PG8_STAGE(PG8_SA(1, 1), a1 + hstep, voffA);
            PG8_WAIT_V(8); PG8_WAIT_L(0); PG8_BAR; PG8_MMA(0, 0, At, B0); PG8_MMA(0, 1, At, B1); PG8_BAR; PG8_SCHED;
            PG8_LDA(At, 0, 1); PG8_STAGE(PG8_SB(0, 0), b2, voffB); PG8_STAGE(PG8_SB(0, 1), b2 + hstep, voffB); PG8_STAGE(PG8_SA(0, 0), a2, voffA);
            PG8_WAIT_V(8); PG8_WAIT_L(0); PG8_BAR; PG8_MMA(1, 0, At, B0); PG8_MMA(1, 1, At, B1); PG8_BAR; PG8_SCHED;
            PG8_LDB(B0, 1, 0); PG8_LDB(B1, 1, 1); PG8_SCHED; PG8_LDA(At, 1, 0); PG8_STAGE(PG8_SA(0, 1), a2 + hstep, voffA);
            PG8_WAIT_V(8); PG8_WAIT_L(0); PG8_BAR; PG8_MMA(0, 0, At, B0); PG8_MMA(0, 1, At, B1); PG8_BAR; PG8_SCHED;
            PG8_LDA(At, 1, 1); PG8_STAGE(PG8_SB(1, 0), b3, voffB); PG8_STAGE(PG8_SB(1, 1), b3 + hstep, voffB); PG8_STAGE(PG8_SA(1, 0), a3, voffA);
            PG8_WAIT_V(8); PG8_WAIT_L(0); PG8_BAR; PG8_MMA(1, 0, At, B0); PG8_MMA(1, 1, At, B1); PG8_BAR; PG8_SCHED;
            } else {
            PG8_LDB(B0, 0, 0); PG8_SCHED; PG8_LDA(At, 0, 0); PG8_STAGE(PG8_SA(1, 1), a1 + hstep, voffA);
            PG8_WAIT_L(8); PG8_BAR; PG8_WAIT_L(0); PG8_MMA(0, 0, At, B0); PG8_BAR; PG8_SCHED;
            PG8_LDB(B1, 0, 1); PG8_STAGE(PG8_SB(0, 0), b2, voffB);
            PG8_BAR; PG8_WAIT_L(0); PG8_MMA(0, 1, At, B1); PG8_BAR;
            PG8_LDA(At, 0, 1); PG8_STAGE(PG8_SA(0, 0), a2, voffA);
            PG8_BAR; PG8_WAIT_L(0); PG8_MMA(1, 0, At, B0); PG8_BAR; PG8_SCHED;
            PG8_STAGE(PG8_SB(0, 1), b2 + hstep, voffB);
            PG8_WAIT_V(6); PG8_BAR; PG8_MMA(1, 1, At, B1); PG8_BAR;
            PG8_LDB(B0, 1, 0); PG8_SCHED; PG8_LDA(At, 1, 0); PG8_STAGE(PG8_SA(0, 1), a2 + hstep, voffA);
            PG8_WAIT_L(8); PG8_BAR; PG8_WAIT_L(0); PG8_MMA(0, 0, At, B0); PG8_BAR; PG8_SCHED;
            PG8_LDB(B1, 1, 1); PG8_STAGE(PG8_SB(1, 0), b3, voffB);
            PG8_BAR; PG8_WAIT_L(0); PG8_MMA(0, 1, At, B1); PG8_BAR;
            PG8_LDA(At, 1, 1); PG8_STAGE(PG8_SA(1, 0), a3, voffA);
            PG8_BAR; PG8_WAIT_L(0); PG8_MMA(1, 0, At, B0); PG8_BAR; PG8_SCHED;
            PG8_STAGE(PG8_SB(1, 1), b3 + hstep, voffB);
            PG8_WAIT_V(6); PG8_BAR; PG8_MMA(1, 1, At, B1); PG8_BAR;
            }
        }
        if constexpr (ALIGN_EPI) { if (wr == 0) PG8_BAR; }
        if constexpr (!Epi::AFTER_DRAIN) { E(acc, cur, wr, wc, fr, fq); S.done(cur); }
        if (!has_next) break;
#pragma unroll
        for (int a = 0; a < 2; ++a)
#pragma unroll
            for (int b = 0; b < 2; ++b)
#pragma unroll
                for (int m = 0; m < 4; ++m)
#pragma unroll
                    for (int n = 0; n < 2; ++n) acc[a][b][m][n] = (f32x4){0.f, 0.f, 0.f, 0.f};
        cur = nxt; cA = nA; cB = nB; ++ui;
        if constexpr (ALIGN_EPI) { if (wr == 1) PG8_BAR; }
    }
    PG8_WAIT_V(0);
    if constexpr (!ALIGN_EPI) { if (wr == 0) PG8_BAR; }
    PG8_BAR;
    if constexpr (Epi::AFTER_DRAIN) { E.fused(acc, cur, wr, wc, fr, fq, lds, wid, lane); S.done(cur); }
#undef PG8_SA
#undef PG8_SB
#undef PG8_STAGE
#undef PG8_LDA
#undef PG8_LDB
#undef PG8_MMA
#undef PG8_WAIT_V
#undef PG8_WAIT_L
#undef PG8_BAR
#undef PG8_SCHED
}
}
#define LAS __attribute__((address_space(3)))
#define GAS __attribute__((address_space(1)))
typedef unsigned v4u __attribute__((ext_vector_type(4)));
typedef float f32x4 __attribute__((ext_vector_type(4)));
constexpr int NWAVES = 8, NTHR = 512;
constexpr int LDS_BYTES = 147456;
constexpr int RING_BYTES = 131072, LDSCTL_OFF = RING_BYTES, MISC_OFF = LDSCTL_OFF + 320;
constexpr int CW_CNT = 0;
constexpr int CW_BAR = 1024;
constexpr size_t CTL_ZERO_BYTES = 64 * 1024;

#define XB_TMO      128
#define XB_XCNT(j)  (256  + 64 * (j))
#define XB_XSUB(j)  (1280 + 64 * (j))
#define XB_XGEN(j)  (2304 + 64 * (j))
#define XB_TOP      3328
#define XB_TOPGEN   3392
#define XCD_BAR_WORDS 3456
#define XB_SPIN_CAP (1u << 18)
DEV unsigned xb_ld(unsigned* p)              { return __hip_atomic_load(p, __ATOMIC_RELAXED, __HIP_MEMORY_SCOPE_AGENT); }
DEV unsigned xb_add(unsigned* p, unsigned v) { return __hip_atomic_fetch_add(p, v, __ATOMIC_RELAXED, __HIP_MEMORY_SCOPE_AGENT); }
DEV unsigned xb_xcc_id() { return (unsigned)__builtin_amdgcn_s_getreg((3 << 11) | 20) & 0xFu; }
#define XB_SPIN(cond, bar) do { unsigned _sp = 0; while (cond) { __builtin_amdgcn_s_sleep(1); \
    if ((++_sp & 255u) == 0u) { if (xb_ld(&(bar)[XB_TMO])) break; if (_sp > XB_SPIN_CAP) { atomicAdd(&(bar)[XB_TMO], 1u); break; } } } } while (0)
struct XcdBarrier { unsigned* bar; unsigned x; volatile LAS unsigned* st; };
DEV XcdBarrier xcd_barrier_post(unsigned* bar, volatile LAS unsigned* st) {
    XcdBarrier b; b.bar = bar; b.x = xb_xcc_id(); b.st = st;
    if (threadIdx.x == 0) (void)xb_add(&bar[XB_XCNT(b.x)], 1u);
    return b;
}
DEV void xcd_barrier_complete(unsigned* bar, unsigned x, unsigned& nloc, unsigned& nx) {
    const unsigned G = gridDim.x * gridDim.y * gridDim.z;
    unsigned sum, cnt, mine, sp = 0u;
    for (;;) {
        sum = 0u; cnt = 0u; mine = 0u;
#pragma unroll
        for (unsigned j = 0; j < 16; ++j) { const unsigned c = xb_ld(&bar[XB_XCNT(j)]); sum += c; cnt += (c > 0u) ? 1u : 0u; mine = (j == x) ? c : mine; }
        if (sum == G) break;
        __builtin_amdgcn_s_sleep(1);
        if ((++sp & 255u) == 0u) { if (xb_ld(&bar[XB_TMO])) break; if (sp > XB_SPIN_CAP) { atomicAdd(&bar[XB_TMO], 1u); break; } }
    }
    nloc = mine > 0u ? mine : 1u; nx = cnt > 0u ? cnt : 1u;
}
DEV void xcd_barrier(const XcdBarrier& b) {
    asm volatile("s_waitcnt vmcnt(0)" ::: "memory");
    __syncthreads();
    if (threadIdx.x == 0) {
        unsigned* bar = b.bar;
        __builtin_amdgcn_s_waitcnt(0);
        unsigned nloc = b.st[0], nx = b.st[1];
        if (nloc == 0u) { xcd_barrier_complete(bar, b.x, nloc, nx); b.st[0] = nloc; b.st[1] = nx; }
        const unsigned old = xb_add(&bar[XB_XSUB(b.x)], 1u);
        const unsigned gen = old / nloc;
        if (old + 1u == (gen + 1u) * nloc) {
            __builtin_amdgcn_fence(__ATOMIC_RELEASE, "agent");
            asm volatile("s_waitcnt vmcnt(0)" ::: "memory");
            const unsigned og = xb_add(&bar[XB_TOP], 1u);
            const unsigned tg = og / nx;
            if (og + 1u == (tg + 1u) * nx) xb_add(&bar[XB_TOPGEN], 1u);
            else XB_SPIN(xb_ld(&bar[XB_TOPGEN]) == tg, bar);
            __builtin_amdgcn_fence(__ATOMIC_ACQUIRE, "agent");
            xb_add(&bar[XB_XGEN(b.x)], 1u);
            asm volatile("s_waitcnt vmcnt(0)" ::: "memory");
        } else {
            XB_SPIN(xb_ld(&bar[XB_XGEN(b.x)]) == gen, bar);
            __builtin_amdgcn_fence(__ATOMIC_ACQUIRE, "agent");
            asm volatile("s_waitcnt vmcnt(0)" ::: "memory");
        }
    }
    __syncthreads();
}

DEV void transpose_item(const float* W, int N, int k0, int n0, bf16* dst, int ldk, LAS float* scr, int lane) {
#pragma unroll 8
    for (int i = 0; i < 32; ++i) { const int kk = 2 * i + (lane >> 5); scr[kk * 33 + (lane & 31)] = W[(size_t)(k0 + kk) * N + n0 + (lane & 31)]; }
    asm volatile("s_waitcnt lgkmcnt(0)" ::: "memory");
    const int c = lane & 7;
#pragma unroll
    for (int j = 0; j < 4; ++j) { const int n = (lane >> 3) + 8 * j; const LAS float* s = scr + (8 * c) * 33 + n;
        v4u o; o.x = pk2(s[0 * 33], s[1 * 33]); o.y = pk2(s[2 * 33], s[3 * 33]); o.z = pk2(s[4 * 33], s[5 * 33]); o.w = pk2(s[6 * 33], s[7 * 33]);
        *(v4u*)(dst + (size_t)n * ldk + k0 + 8 * c) = o; }
    asm volatile("s_waitcnt lgkmcnt(0)" ::: "memory");
}
DEV void ph_prep1(const float* w_in, const float* w_out, const float* rgw, const float* rew, bf16* win_t, bf16* wout_t, float* wrt, LAS float* scr, int gw, int NGW, int lane) {
    constexpr int I_IN = (D / 64) * (DIN / 32), I_OUT = (D / 64) * (D / 32);
    for (int it = gw; it < I_IN + I_OUT; it += NGW) {
        if (it < I_IN) { const int nblk = DIN / 32, kb = it / nblk, nb = it % nblk; transpose_item(w_in, DIN, 64 * kb, 32 * nb, win_t + (size_t)(32 * nb) * D, D, scr, lane); }
        else { const int r = it - I_IN, nblk = D / 32, kb = r / nblk, nb = r % nblk; transpose_item(w_out, D, 64 * kb, 32 * nb, wout_t + (size_t)(32 * nb) * D, D, scr, lane); }
    }
    for (int i = gw * 64 + lane; i < 36 * 1024; i += NGW * 64) { const int e = i >> 10, d = i & 1023; wrt[i] = e < 4 ? rgw[d * 4 + e] : rew[d * 32 + (e - 4)]; }
}
DEV void ph_prep2(const float* wg, const float* wu, const float* wd, bf16* wgu_t, bf16* wd_t, LAS float* scr, int gw, int NGW, int lane) {
    constexpr int I_G = (D / 64) * (DE / 32), I_D = (DE / 64) * (D / 32), PER_E = 2 * I_G + I_D;
    for (int it = gw; it < NE * PER_E; it += NGW) {
        const int e = it / PER_E; int r = it % PER_E;
        if (r < 2 * I_G) { const int up = r >= I_G; if (up) r -= I_G; const int nblk = DE / 32, kb = r / nblk, nb = r % nblk, n0 = 32 * nb;
            const float* W = (up ? wu : wg) + (size_t)e * D * DE;
            bf16* dst = wgu_t + ((size_t)e * 1024 + (n0 >> 7) * 256 + up * 128 + (n0 & 127)) * D;
            transpose_item(W, DE, 64 * kb, n0, dst, D, scr, lane); }
        else { r -= 2 * I_G; const int nblk = D / 32, kb = r / nblk, nb = r % nblk, n0 = 32 * nb;
            transpose_item(wd + (size_t)e * DE * D, D, 64 * kb, n0, wd_t + ((size_t)e * D + n0) * DE, DE, scr, lane); }
    }
}
DEV void ph_rmsnorm(const float* x, const float* g, bf16* out, int gw, int NGW, int lane) {
    for (int row = gw; row < T; row += NGW) {
        const f32x4* xr = (const f32x4*)(x + (size_t)row * D) + lane; const f32x4* gr = (const f32x4*)g + lane;
        f32x4 v[4]; float s = 0.f;
#pragma unroll
        for (int j = 0; j < 4; ++j) { v[j] = xr[64 * j]; s += (v[j].x * v[j].x + v[j].y * v[j].y) + (v[j].z * v[j].z + v[j].w * v[j].w); }
        const float rstd = rsqrtf(wave_sum(s) * (1.f / D) + RMS_EPS);
        unsigned long long* o8 = (unsigned long long*)(out + (size_t)row * D) + lane;
#pragma unroll
        for (int j = 0; j < 4; ++j) { const f32x4 gg = gr[64 * j]; o8[64 * j] = (unsigned long long)pk2(v[j].x * rstd * gg.x, v[j].y * rstd * gg.y) | ((unsigned long long)pk2(v[j].z * rstd * gg.z, v[j].w * rstd * gg.w) << 32); }
    }
}

DEV void ph_rwkv_pre(const bf16* p, const float* mu, const float* w0, const float* w_up, const float* a0, const float* a_up, const float* g_up,
                     const float* k_k, const float* k_a, float* decay, float* kk, float* bb, float* kp, float* gg, LAS float* xs, int blk, int NBLK, int tid) {
    for (int t = blk; t < T; t += NBLK) {
        const int s = t % SEQ;
        __syncthreads();
        for (int c = tid; c < DRIN; c += NTHR) { const float cur = bf2f(p[(size_t)t * DIN + c]); const float prev = s > 0 ? bf2f(p[(size_t)(t - 1) * DIN + c]) : 0.f; xs[c] = cur + mu[c] * (prev - cur); }
        __syncthreads();
        { const int j = tid; if (j < 64) xs[1536 + j] = tanhf(xs[1536 + j]); else if (j >= 128 && j < 256) xs[1536 + j] = sigmoidf_(xs[1536 + j]); }
        __syncthreads();
        const int c = tid;
        float zw = w0[c], za = a0[c], g = 0.f;
#pragma unroll 8
        for (int j = 0; j < 64; ++j) { zw += xs[1536 + j] * w_up[j * DR + c]; za += xs[1600 + j] * a_up[j * DR + c]; }
#pragma unroll 8
        for (int j = 0; j < 128; ++j) g += xs[1664 + j] * g_up[j * DR + c];
        const float nz = -zw, sp = fmaxf(nz, 0.f) + log1pf(__expf(-fabsf(nz)));
        const float wlog = -sp - 0.5f, dec = __expf(-__expf(wlog));
        const float a = sigmoidf_(za);
        const float kraw = xs[512 + c], kkp = kraw * k_k[c];
        const float nrm = sqrtf(wave_sum(kkp * kkp));
        const float kkv = kkp / fmaxf(nrm, L2_EPS);
        const size_t o = (size_t)t * DR + c;
        decay[o] = dec; kk[o] = kkv; bb[o] = kkv * a; kp[o] = kraw * (1.f + (a - 1.f) * k_a[c]); gg[o] = g;
    }
}
DEV void rwkv_scan_unit(int unit, const bf16* p, const float* mu, const float* decay, const float* kk, const float* bb, const float* kp, const float* gg,
                        const float* r_k, const float* ln_w, const float* ln_b, bf16* mix, int lane) {
    const int b = unit >> 3, h = unit & 7, ch = h * 64 + lane;
    float s[64];
#pragma unroll
    for (int k = 0; k < 64; ++k) s[k] = 0.f;
    const float mur = mu[ch], muv = mu[1024 + ch], rk = r_k[ch], lw = ln_w[ch], lb = ln_b[ch];
    size_t t = (size_t)b * SEQ;
    float n_kk = kk[t * DR + ch], n_w = decay[t * DR + ch], n_b = bb[t * DR + ch], n_k = kp[t * DR + ch], n_g = gg[t * DR + ch];
    float n_pr = bf2f(p[t * DIN + ch]), n_pv = bf2f(p[t * DIN + 1024 + ch]);
    float prev_r = 0.f, prev_v = 0.f;
    for (int step = 0; step < SEQ; ++step, ++t) {
        const float kkl = n_kk, wl = n_w, bl = n_b, kl = n_k, gl = n_g, pr = n_pr, pv = n_pv;
        if (step + 1 < SEQ) { const size_t t1 = t + 1; n_kk = kk[t1 * DR + ch]; n_w = decay[t1 * DR + ch]; n_b = bb[t1 * DR + ch]; n_k = kp[t1 * DR + ch]; n_g = gg[t1 * DR + ch];
            n_pr = bf2f(p[t1 * DIN + ch]); n_pv = bf2f(p[t1 * DIN + 1024 + ch]); }
        const float rl = pr + mur * (prev_r - pr), vl = pv + muv * (prev_v - pv);
        prev_r = pr; prev_v = pv;
        float sa0 = 0.f, sa1 = 0.f, sa2 = 0.f, sa3 = 0.f;
#pragma unroll
        for (int k = 0; k < 64; k += 4) { sa0 += s[k] * rdlane(kkl, k); sa1 += s[k + 1] * rdlane(kkl, k + 1); sa2 += s[k + 2] * rdlane(kkl, k + 2); sa3 += s[k + 3] * rdlane(kkl, k + 3); }
        const float sa = -((sa0 + sa1) + (sa2 + sa3));
        float y0 = 0.f, y1 = 0.f, y2 = 0.f, y3 = 0.f;
#pragma unroll
        for (int k = 0; k < 64; k += 4) {
            s[k] = s[k] * rdlane(wl, k) + sa * rdlane(bl, k) + vl * rdlane(kl, k);                 y0 += s[k] * rdlane(rl, k);
            s[k + 1] = s[k + 1] * rdlane(wl, k + 1) + sa * rdlane(bl, k + 1) + vl * rdlane(kl, k + 1); y1 += s[k + 1] * rdlane(rl, k + 1);
            s[k + 2] = s[k + 2] * rdlane(wl, k + 2) + sa * rdlane(bl, k + 2) + vl * rdlane(kl, k + 2); y2 += s[k + 2] * rdlane(rl, k + 2);
            s[k + 3] = s[k + 3] * rdlane(wl, k + 3) + sa * rdlane(bl, k + 3) + vl * rdlane(kl, k + 3); y3 += s[k + 3] * rdlane(rl, k + 3);
        }
        const float y = (y0 + y1) + (y2 + y3);
        const float mean = wave_sum(y) * (1.f / 64.f), d = y - mean, var = wave_sum(d * d) * (1.f / 64.f);
        const float yn = d * rsqrtf(var + GN_EPS) * lw + lb;
        const float bonus = wave_sum(rl * kl * rk);
        mix[t * D + ch] = (bf16)f2bf((yn + bonus * vl) * gl);
    }
}

DEV void ph_hgrn_pre(const bf16* p, const float* cw, const float* lbl, float* hq, float* hf, float* hv, int blk, int NBLK, int tid) {
    const int c = tid;
    const float lb = 1.f / (1.f + __expf(lbl[512 + c] - lbl[c]));
    for (int t = blk; t < T; t += NBLK) {
        const int s = t % SEQ;
        float xq = 0.f, xf = 0.f, xi = 0.f;
#pragma unroll
        for (int j = 0; j < 4; ++j) { const int sp = s - 3 + j; if (sp >= 0) { const bf16* row = p + (size_t)(t - 3 + j) * DIN + DRIN;
            xq += cw[j * 1536 + c] * bf2f(row[c]); xf += cw[j * 1536 + 512 + c] * bf2f(row[512 + c]); xi += cw[j * 1536 + 1024 + c] * bf2f(row[1024 + c]); } }
        const size_t o = (size_t)t * DH + c;
        hq[o] = xq * sigmoidf_(xq); hf[o] = lb + (1.f - lb) * sigmoidf_(xf); hv[o] = xi;
    }
}
DEV void hgrn_scan_unit(int unit, const float* hq, const float* hf, const float* hv, float* op0, float* op1, int tid2) {
    const int half = unit & 1, h = (unit >> 1) & 3, b = unit >> 3, lane = tid2 & 63;
    float* op = half ? op1 : op0;
    float s[64];
#pragma unroll
    for (int k = 0; k < 64; ++k) s[k] = 0.f;
    size_t t = (size_t)b * SEQ;
    const int kc = h * 128 + half * 64 + lane, vc = h * 128 + tid2;
    float n_q = hq[t * DH + kc], n_f = hf[t * DH + kc], n_v = hv[t * DH + vc];
    for (int step = 0; step < SEQ; ++step, ++t) {
        const float ql = n_q, fl = n_f, vl = n_v, khl = 1.f - fl;
        if (step + 1 < SEQ) { n_q = hq[(t + 1) * DH + kc]; n_f = hf[(t + 1) * DH + kc]; n_v = hv[(t + 1) * DH + vc]; }
        float o0 = 0.f, o1 = 0.f, o2 = 0.f, o3 = 0.f;
#pragma unroll
        for (int k = 0; k < 64; k += 4) {
            s[k] = s[k] * rdlane(fl, k) + rdlane(khl, k) * vl;                 o0 += rdlane(ql, k) * s[k];
            s[k + 1] = s[k + 1] * rdlane(fl, k + 1) + rdlane(khl, k + 1) * vl; o1 += rdlane(ql, k + 1) * s[k + 1];
            s[k + 2] = s[k + 2] * rdlane(fl, k + 2) + rdlane(khl, k + 2) * vl; o2 += rdlane(ql, k + 2) * s[k + 2];
            s[k + 3] = s[k + 3] * rdlane(fl, k + 3) + rdlane(khl, k + 3) * vl; o3 += rdlane(ql, k + 3) * s[k + 3];
        }
        op[t * DH + vc] = (o0 + o1) + (o2 + o3);
    }
}
DEV void ph_hgrn_post(const bf16* p, const float* op0, const float* op1, const float* ng, bf16* mix, LAS float* red, int blk, int NBLK, int tid) {
    const int c = tid, wave = c >> 6;
    for (int t = blk; t < T; t += NBLK) {
        const float o = op0[(size_t)t * DH + c] + op1[(size_t)t * DH + c];
        const float ws = wave_sum(o * o);
        __syncthreads();
        if ((c & 63) == 0) red[wave] = ws;
        __syncthreads();
        const float ms = (red[(wave & ~1)] + red[(wave | 1)]) * (1.f / 128.f);
        const float g = bf2f(p[(size_t)t * DIN + DRIN + 1536 + c]);
        mix[(size_t)t * D + 512 + c] = (bf16)f2bf(o * rsqrtf(ms + RMS_EPS) * ng[c] * (g * sigmoidf_(g)));
    }
}
DEV void ph_norm2_router(const float* h, const float* g2, const float* wrt, const float* bg, const float* be, bf16* hn,
                         unsigned* cnt, int* tok_e, int* tok_pos, float* tok_gate, int gw, int NGW, int lane) {
    for (int t = gw; t < T; t += NGW) {
        const f32x4* xr = (const f32x4*)(h + (size_t)t * D) + lane; const f32x4* gr = (const f32x4*)g2 + lane;
        f32x4 v[4]; float s = 0.f;
#pragma unroll
        for (int j = 0; j < 4; ++j) { v[j] = xr[64 * j]; s += (v[j].x * v[j].x + v[j].y * v[j].y) + (v[j].z * v[j].z + v[j].w * v[j].w); }
        const float rstd = rsqrtf(wave_sum(s) * (1.f / D) + RMS_EPS);
        unsigned long long* o8 = (unsigned long long*)(hn + (size_t)t * D) + lane;
#pragma unroll
        for (int j = 0; j < 4; ++j) { v[j] = v[j] * rstd * gr[64 * j]; o8[64 * j] = (unsigned long long)pk2(v[j].x, v[j].y) | ((unsigned long long)pk2(v[j].z, v[j].w) << 32); }
        float L[36];
#pragma unroll
        for (int e = 0; e < 36; ++e) { const float* wp = wrt + e * D; asm volatile("" : "+s"(wp)); const f32x4* wr = (const f32x4*)wp + lane; float a = 0.f;
#pragma unroll
            for (int j = 0; j < 4; ++j) { const f32x4 w = wr[64 * j]; a += (v[j].x * w.x + v[j].y * w.y) + (v[j].z * w.z + v[j].w * w.w); }
            L[e] = wave_sum(a); asm volatile("" ::: "memory"); }
        float gl[4]; float gm = -1e30f; int gi = 0;
#pragma unroll
        for (int g = 0; g < 4; ++g) { gl[g] = L[g] + bg[g]; if (gl[g] > gm) { gm = gl[g]; gi = g; } }
        float gs = 0.f;
#pragma unroll
        for (int g = 0; g < 4; ++g) gs += __expf(gl[g] - gm);
        const float g_w = 1.f / gs;
        float el[8];
#pragma unroll
        for (int j = 0; j < 8; ++j) el[j] = 0.f;
#pragma unroll
        for (int g = 0; g < 4; ++g) if (g == gi) {
#pragma unroll
            for (int j = 0; j < 8; ++j) el[j] = L[4 + 8 * g + j] + be[8 * g + j]; }
        float m1 = -1e30f; int i1 = 0;
#pragma unroll
        for (int j = 0; j < 8; ++j) if (el[j] > m1) { m1 = el[j]; i1 = j; }
        float m2 = -1e30f; int i2 = 0;
#pragma unroll
        for (int j = 0; j < 8; ++j) if (j != i1 && el[j] > m2) { m2 = el[j]; i2 = j; }
        const float p2 = __expf(m2 - m1), w1 = 1.f / (1.f + p2), w2 = p2 / (1.f + p2);
        if (lane == 0) {
            const int e1 = gi * 8 + i1, e2 = gi * 8 + i2;
            const unsigned q1 = atomicAdd(cnt + e1, 1u), q2 = atomicAdd(cnt + e2, 1u);
            tok_e[2 * t] = e1; tok_e[2 * t + 1] = e2; tok_pos[2 * t] = (int)q1; tok_pos[2 * t + 1] = (int)q2; tok_gate[2 * t] = g_w * w1; tok_gate[2 * t + 1] = g_w * w2;
        }
    }
}
DEV void ph_scatter(const bf16* hn, const unsigned* cnt, const int* tok_e, const int* tok_pos, int* misc, bf16* xg, int* tok_slot, LAS int* offs, int gw, int NGW, int lane, int tid) {
    __syncthreads();
    if (tid == 0) { int off = 0, nt = 0; const bool wr = blockIdx.x == 0;
        for (int e = 0; e < NE; ++e) { const int c = (int)__hip_atomic_load(cnt + e, __ATOMIC_RELAXED, __HIP_MEMORY_SCOPE_AGENT), tiles = (c + 255) >> 8; offs[e] = off;
            if (wr) for (int i = 0; i < tiles; ++i) misc[64 + nt + i] = e;
            nt += tiles; off += tiles * 256; }
        if (wr) misc[0] = nt; }
    __syncthreads();
    for (int t = gw; t < T; t += NGW) {
        const v4u* src = (const v4u*)(hn + (size_t)t * D) + lane;
        const v4u a = src[0], b = src[64];
#pragma unroll
        for (int k = 0; k < 2; ++k) { const int e = tok_e[2 * t + k], slot = offs[e] + tok_pos[2 * t + k];
            v4u* dst = (v4u*)(xg + (size_t)slot * D) + lane; dst[0] = a; dst[64] = b;
            if (lane == 0) tok_slot[2 * t + k] = slot; }
    }
}
DEV void ph_final(float* h, const bf16* yo, const int* tok_slot, const float* tok_gate, const float* gf, int gw, int NGW, int lane) {
    for (int t = gw; t < T; t += NGW) {
        f32x4* xr = (f32x4*)(h + (size_t)t * D) + lane; const f32x4* gr = (const f32x4*)gf + lane;
        const int s1 = tok_slot[2 * t], s2 = tok_slot[2 * t + 1]; const float g1 = tok_gate[2 * t], g2 = tok_gate[2 * t + 1];
        const unsigned long long* y1 = (const unsigned long long*)(yo + (size_t)s1 * D) + lane; const unsigned long long* y2 = (const unsigned long long*)(yo + (size_t)s2 * D) + lane;
        f32x4 v[4]; float s = 0.f;
#pragma unroll
        for (int j = 0; j < 4; ++j) { v[j] = xr[64 * j]; const unsigned long long a = y1[64 * j], b = y2[64 * j];
            v[j].x += g1 * bf2f((bf16)(a & 0xffff)) + g2 * bf2f((bf16)(b & 0xffff));
            v[j].y += g1 * bf2f((bf16)((a >> 16) & 0xffff)) + g2 * bf2f((bf16)((b >> 16) & 0xffff));
            v[j].z += g1 * bf2f((bf16)((a >> 32) & 0xffff)) + g2 * bf2f((bf16)((b >> 32) & 0xffff));
            v[j].w += g1 * bf2f((bf16)(a >> 48)) + g2 * bf2f((bf16)(b >> 48));
            s += (v[j].x * v[j].x + v[j].y * v[j].y) + (v[j].z * v[j].z + v[j].w * v[j].w); }
        const float rstd = rsqrtf(wave_sum(s) * (1.f / D) + RMS_EPS);
#pragma unroll
        for (int j = 0; j < 4; ++j) xr[64 * j] = v[j] * rstd * gr[64 * j];
    }
}

#ifndef MK_N_LAUNCHES
#define MK_N_LAUNCHES 1
#endif
constexpr int N_PHASES = 13;
struct Args { const float* in[27]; float* out; unsigned char* ws; int ph_lo, ph_hi; };
__global__ void __launch_bounds__(NTHR, 2) mega_kernel(Args args) {
    extern __shared__ __attribute__((aligned(16))) unsigned char lds_raw[];
    LAS unsigned char* lds = (LAS unsigned char*)lds_raw;
    volatile LAS unsigned* MISC = (volatile LAS unsigned*)(lds + MISC_OFF);
    const int tid = threadIdx.x, lane = tid & 63, wave = __builtin_amdgcn_readfirstlane(tid >> 6);
    const int G = gridDim.x, blk = blockIdx.x, gw = blk * NWAVES + wave, NGW = G * NWAVES;
    unsigned char* ws = args.ws; float* out = args.out; const float* const* in = args.in;
    bf16 *win_t = (bf16*)(ws + WS_WIN), *wout_t = (bf16*)(ws + WS_WOUT), *wgu_t = (bf16*)(ws + WS_WGU), *wd_t = (bf16*)(ws + WS_WD);
    bf16 *xn = (bf16*)(ws + WS_XN), *p = (bf16*)(ws + WS_P), *xg = (bf16*)(ws + WS_XG), *H = (bf16*)(ws + WS_H), *yo = (bf16*)(ws + WS_YO);
    float* wrt = (float*)(ws + WS_WRT); unsigned* ctl = (unsigned*)(ws + WS_CTL); unsigned* cnt = ctl + CW_CNT; int* misc = (int*)(ws + WS_MISC);
    int* tok_e = (int*)(ws + WS_TOK); int* tok_pos = tok_e + 2 * T; float* tok_gate = (float*)(tok_pos + 2 * T); int* tok_slot = (int*)(tok_gate + 2 * T);
    float *S0 = (float*)(ws + WS_S0), *S1 = (float*)(ws + WS_S1), *S2 = (float*)(ws + WS_S2), *S3 = out, *S4 = out + (size_t)T * 512;
    for (int u = tid; u < (LDS_BYTES - LDSCTL_OFF) / 4; u += NTHR) ((LAS unsigned*)(lds + LDSCTL_OFF))[u] = 0u;
    __syncthreads();
    XcdBarrier bar; bar.bar = ctl + CW_BAR; bar.x = 0; bar.st = nullptr;
    const int lo = args.ph_lo, hi = args.ph_hi;
    if (hi - lo > 1) bar = xcd_barrier_post(ctl + CW_BAR, MISC + 8);
#define IN(k) (lo <= (k) && (k) < hi)
#define SEAM(k) do { if (IN(k) && IN((k) + 1)) xcd_barrier(bar); } while (0)
    LAS float* wscr = (LAS float*)(lds + wave * 16384);

    if (IN(0)) { ph_prep1(in[2], in[17], in[19], in[21], win_t, wout_t, wrt, wscr, gw, NGW, lane); ph_rmsnorm(in[0], in[1], xn, gw, NGW, lane); }
    SEAM(0);
    if (IN(1)) { pg8::Gemm g{D}; pg8::StaticOrder S; S.init(xn, win_t, T, DIN, D, G, blk); pg8::EpiBf16 E{p, DIN};
        pg8::gemm_phase<pg8::EpiBf16, pg8::StaticOrder, true, true>(lds, g, S, E); }
    SEAM(1);
    if (IN(2)) ph_rwkv_pre(p, in[3], in[4], in[5], in[6], in[7], in[8], in[9], in[10], S0, S1, S2, S3, S4, (LAS float*)lds, blk, G, tid);
    SEAM(2);
    if (IN(3)) { if (blk < 64 && wave == 0) rwkv_scan_unit(blk, p, in[3], S0, S1, S2, S3, S4, in[11], in[12], in[13], xn, lane); }
    SEAM(3);
    if (IN(4)) ph_hgrn_pre(p, in[14], in[15], S0, S1, S2, blk, G, tid);
    SEAM(4);
    if (IN(5)) { if (blk < 64 && wave < 2) hgrn_scan_unit(blk, S0, S1, S2, S3, S4, tid); }
    SEAM(5);
    if (IN(6)) { ph_hgrn_post(p, S3, S4, in[16], xn, (LAS float*)lds, blk, G, tid); __syncthreads(); ph_prep2(in[23], in[24], in[25], wgu_t, wd_t, wscr, gw, NGW, lane); }
    SEAM(6);
    if (IN(7)) { pg8::Gemm g{D}; pg8::StaticOrder S; S.init(xn, wout_t, T, D, D, G, blk); pg8::EpiResF32 E{in[0], out, D};
        pg8::gemm_phase<pg8::EpiResF32, pg8::StaticOrder, true, true>(lds, g, S, E); }
    SEAM(7);
    if (IN(8)) ph_norm2_router(out, in[18], wrt, in[20], in[22], xn, cnt, tok_e, tok_pos, tok_gate, gw, NGW, lane);
    SEAM(8);
    if (IN(9)) ph_scatter(xn, cnt, tok_e, tok_pos, misc, xg, tok_slot, (LAS int*)lds, gw, NGW, lane, tid);
    SEAM(9);
    if (IN(10)) { const int ntiles = __builtin_amdgcn_readfirstlane(misc[0]); pg8::Gemm g{D}; pg8::MoeOrder S; S.init(xg, wgu_t, misc + 64, ntiles, 1024, D, G, blk); pg8::EpiSwiGLU E{H, DE};
        pg8::gemm_phase<pg8::EpiSwiGLU, pg8::MoeOrder, true, true>(lds, g, S, E); }
    SEAM(10);
    if (IN(11)) { const int ntiles = __builtin_amdgcn_readfirstlane(misc[0]); pg8::Gemm g{DE}; pg8::MoeOrder S; S.init(H, wd_t, misc + 64, ntiles, D, DE, G, blk); pg8::EpiBf16 E{yo, D};
        pg8::gemm_phase<pg8::EpiBf16, pg8::MoeOrder, true, true>(lds, g, S, E); }
    SEAM(11);
    if (IN(12)) ph_final(out, yo, tok_slot, tok_gate, in[26], gw, NGW, lane);
#undef IN
#undef SEAM
}

extern "C" void kernel_launch(void* const* d_in, const int* in_sizes, int n_in, void* d_out, int out_size, void* d_ws, size_t ws_size, hipStream_t stream) {
    static int grid = 0;
    if (grid == 0) {
        if (n_in != 27 || in_sizes[0] != T * D || out_size != T * D || ws_size < WS_END) { fprintf(stderr, "kernel_launch: unexpected shapes (n_in %d, in0 %d, out %d, ws %zu)\n", n_in, n_in > 0 ? in_sizes[0] : -1, out_size, ws_size); grid = -1; return; }
        int dev = 0, cus = 0;
        if (hipGetDevice(&dev) != hipSuccess || hipDeviceGetAttribute(&cus, hipDeviceAttributeMultiprocessorCount, dev) != hipSuccess) { grid = -1; return; }
        if (hipFuncSetAttribute((const void*)mega_kernel, hipFuncAttributeMaxDynamicSharedMemorySize, LDS_BYTES) != hipSuccess) { fprintf(stderr, "kernel_launch: hipFuncSetAttribute failed\n"); grid = -1; return; }
        grid = cus;
    }
    if (grid < 0) return;
    if (hipMemsetAsync((char*)d_ws + WS_CTL, 0, CTL_ZERO_BYTES, stream) != hipSuccess) return;
    Args a{};
    for (int i = 0; i < 27; ++i) a.in[i] = (const float*)d_in[i];
    a.out = (float*)d_out; a.ws = (unsigned char*)d_ws;
    if (MK_N_LAUNCHES == 1) { a.ph_lo = 0; a.ph_hi = N_PHASES; hipLaunchKernelGGL(mega_kernel, dim3(grid), dim3(NTHR), LDS_BYTES, stream, a); }
    else for (int k = 0; k < N_PHASES; ++k) { a.ph_lo = k; a.ph_hi = k + 1; hipLaunchKernelGGL(mega_kernel, dim3(grid), dim3(NTHR), LDS_BYTES, stream, a); }
}
```

```cpp
#include <hip/hip_runtime.h>
#include <cstdint>
#include <cstdio>

typedef unsigned short bf16;
#define DEV __device__ __forceinline__
DEV float bf2f(bf16 v) { return __uint_as_float(((unsigned)v) << 16); }
DEV unsigned f2bf(float f) { unsigned u = __float_as_uint(f); return (u + 0x7fffu + ((u >> 16) & 1u)) >> 16; }
DEV unsigned pk2(float lo, float hi) { return f2bf(lo) | (f2bf(hi) << 16); }
typedef float f32x2_t __attribute__((ext_vector_type(2)));
typedef __bf16 bf16x2_t __attribute__((ext_vector_type(2)));
DEV unsigned cvt_pk_bf16(float lo, float hi) { const f32x2_t v = {lo, hi}; return __builtin_bit_cast(unsigned, __builtin_convertvector(v, bf16x2_t)); }
DEV float wave_sum(float v) {
#pragma unroll
    for (int o = 1; o < 64; o <<= 1) v += __shfl_xor(v, o);
    return v;
}
DEV float rdlane(float x, int k) { return __uint_as_float(__builtin_amdgcn_readlane(__float_as_uint(x), k)); }
DEV float sigmoidf_(float x) { return 1.0f / (1.0f + __expf(-x)); }

constexpr int BATCH = 8, SEQ = 2048, T = BATCH * SEQ, D = 1024;
constexpr int DR = 512, DH = 512, DRIN = 1792, DHIN = 2048, DIN = 3840;
constexpr int NE = 32, DE = 512;
constexpr float RMS_EPS = 1e-6f, GN_EPS = 64e-5f, L2_EPS = 1e-12f;
constexpr int MAXTILES = 160, MP = MAXTILES * 256;

constexpr size_t MiB = 1u << 20;
constexpr size_t WS_CTL = 0;
constexpr size_t WS_MISC = 64 * 1024;
constexpr size_t WS_WRT = 256 * 1024;
constexpr size_t WS_TOK = 512 * 1024;
constexpr size_t WS_WIN = 1 * MiB;
constexpr size_t WS_WOUT = 9 * MiB;
constexpr size_t WS_WGU = 11 * MiB;
constexpr size_t WS_WD = 75 * MiB;
constexpr size_t WS_XN = 107 * MiB;
constexpr size_t WS_P = 139 * MiB;
constexpr size_t WS_XG = WS_P, WS_H = WS_P + 80 * MiB, WS_YO = WS_P;
constexpr size_t WS_END = 259 * MiB;
constexpr size_t WS_IAR = 11 * MiB;
constexpr size_t WS_GR = 75 * MiB;
constexpr size_t WS_GCR = 91 * MiB;
constexpr size_t WS_BONUS = 91 * MiB + 512 * 1024;
constexpr size_t WS_DCH = 92 * MiB;
constexpr size_t WS_LORA = 8 * MiB + 512 * 1024;
namespace pg8 {
#define PG8_LAS __attribute__((address_space(3)))
typedef unsigned short bf16_t;
typedef short bf16x8 __attribute__((ext_vector_type(8)));
typedef float f32x4 __attribute__((ext_vector_type(4)));
typedef unsigned u32x4 __attribute__((ext_vector_type(4)));
constexpr int BM = 256, BK = 64, HALF = 128, HTB = HALF * BK * 2  , STAGE_BYTES = 8 * HTB, NXCD = 8, WGM = 8;

__host__ __device__ __forceinline__ int lds_byte(int r, int c) { const int st = (r >> 4) * 2 + (c >> 5), rr = r & 15, cc = c & 31, ob = rr * 64 + cc * 2; return st * 1024 + (ob ^ (((ob >> 9) & 1) << 5)); }
__host__ __device__ __forceinline__ void stage_rc(int b, int& R, int& C) { const int st = b / 1024, sb = b % 1024, swz = sb ^ (((sb >> 9) & 1) << 5); R = (st >> 1) * 16 + swz / 64; C = (st & 1) * 32 + (swz % 64) / 2; }
__host__ __device__ __forceinline__ int perm32(int rho) { const int n = rho >> 4, i = rho & 15; return 8 * (i >> 2) + 4 * n + (i & 3); }

struct Unit { int pm, pn; const char* a; const char* b; };
struct Gemm { int K; };

__device__ __forceinline__ bool order_unit(long L, int nM, int nN, int& pm, int& pn) {
    const int nwg = nM * nN; if (L >= nwg) return false;
    int wgid = (int)L; { const int q = nwg / NXCD, r = nwg % NXCD, xcd = wgid % NXCD, off = wgid / NXCD; wgid = (xcd < r ? xcd * (q + 1) : r * (q + 1) + (xcd - r) * q) + off; }
    const int nig = WGM * nN, gid = wgid / nig, fm = gid * WGM, gsz = (nM - fm) < WGM ? (nM - fm) : WGM;
    pm = fm + ((wgid % nig) % gsz); pn = (wgid % nig) / gsz; return true;
}
struct StaticOrder {
    const char* A; const char* Bt; int nM, nN, G, c; size_t tstep;
    __device__ void init(const void* A_, const void* Bt_, int M, int N, int K, int G_, int c_) { A = (const char*)A_; Bt = (const char*)Bt_; nM = M / BM; nN = N / BM; G = G_; c = c_; tstep = (size_t)BM * K * 2; }
    __device__ bool next(int i, Unit& u) const {
        if (!order_unit((long)i * G + c, nM, nN, u.pm, u.pn)) return false;
        u.a = A + (size_t)u.pm * tstep; u.b = Bt + (size_t)u.pn * tstep; return true;
    }
    __device__ __forceinline__ void a_ready(const Unit&) const {}
    __device__ __forceinline__ void done(const Unit&) const {}
};
struct MoeOrder {
    const char* A; const char* Bt; const int* tile_expert; int nM, nN, G, c; size_t tstep, estep;
    __device__ void init(const void* A_, const void* Bt_, const int* te, int ntiles, int N, int K, int G_, int c_) { A = (const char*)A_; Bt = (const char*)Bt_; tile_expert = te; nM = ntiles; nN = N / BM; G = G_; c = c_; tstep = (size_t)BM * K * 2; estep = (size_t)N * K * 2; }
    __device__ bool next(int i, Unit& u) const {
        if (!order_unit((long)i * G + c, nM, nN, u.pm, u.pn)) return false;
        const int e = __builtin_amdgcn_readfirstlane(tile_expert[u.pm]);
        u.a = A + (size_t)u.pm * tstep; u.b = Bt + (size_t)e * estep + (size_t)u.pn * tstep; return true;
    }
    __device__ __forceinline__ void a_ready(const Unit&) const {}
    __device__ __forceinline__ void done(const Unit&) const {}
};

using ::cvt_pk_bf16;

struct EpiBf16 {
    static constexpr bool PERM = true, AFTER_DRAIN = false;
    bf16_t* O; int ldc;
    __device__ __forceinline__ void operator()(const f32x4 (&acc)[2][2][4][2], const Unit& u, int wr, int wc, int fr, int fq) const {
        const int row0 = u.pm * BM + wr * 64 + fr, col0 = u.pn * BM + wc * 32 + 8 * fq;
#pragma unroll
        for (int ai = 0; ai < 2; ++ai)
#pragma unroll
            for (int m = 0; m < 4; ++m) { bf16_t* rowp = O + (size_t)(row0 + ai * HALF + m * 16) * ldc + col0;
#pragma unroll
                for (int bj = 0; bj < 2; ++bj) { const f32x4 v0 = acc[ai][bj][m][0], v1 = acc[ai][bj][m][1];
                    u32x4 w; w.x = cvt_pk_bf16(v0[0], v0[1]); w.y = cvt_pk_bf16(v0[2], v0[3]); w.z = cvt_pk_bf16(v1[0], v1[1]); w.w = cvt_pk_bf16(v1[2], v1[3]);
                    *(u32x4*)(rowp + bj * HALF) = w; } }
    }
};
struct EpiResF32 {
    static constexpr bool PERM = false, AFTER_DRAIN = false;
    const float* base; float* C; int ldc;
    __device__ __forceinline__ void operator()(const f32x4 (&acc)[2][2][4][2], const Unit& u, int wr, int wc, int fr, int fq) const {
        const int row0 = u.pm * BM + wr * 64 + fr, col0 = u.pn * BM + wc * 32 + 4 * fq;
#pragma unroll
        for (int ai = 0; ai < 2; ++ai)
#pragma unroll
            for (int m = 0; m < 4; ++m) { const size_t off = (size_t)(row0 + ai * HALF + m * 16) * ldc + col0;
#pragma unroll
                for (int bj = 0; bj < 2; ++bj)
#pragma unroll
                    for (int n = 0; n < 2; ++n) *(f32x4*)(C + off + bj * HALF + n * 16) = *(const f32x4*)(base + off + bj * HALF + n * 16) + acc[ai][bj][m][n]; }
    }
};
struct EpiSwiGLU {
    static constexpr bool PERM = true, AFTER_DRAIN = false;
    bf16_t* H; int ldh;
    __device__ __forceinline__ void operator()(const f32x4 (&acc)[2][2][4][2], const Unit& u, int wr, int wc, int fr, int fq) const {
        const int row0 = u.pm * BM + wr * 64 + fr, col0 = u.pn * HALF + wc * 32 + 8 * fq;
#pragma unroll
        for (int ai = 0; ai < 2; ++ai)
#pragma unroll
            for (int m = 0; m < 4; ++m) { bf16_t* rowp = H + (size_t)(row0 + ai * HALF + m * 16) * ldh + col0;
                float o[8];
#pragma unroll
                for (int n = 0; n < 2; ++n)
#pragma unroll
                    for (int j = 0; j < 4; ++j) { const float g = acc[ai][0][m][n][j], up = acc[ai][1][m][n][j]; o[n * 4 + j] = g * up * __builtin_amdgcn_rcpf(1.0f + __expf(-g)); }
                u32x4 w; w.x = cvt_pk_bf16(o[0], o[1]); w.y = cvt_pk_bf16(o[2], o[3]); w.z = cvt_pk_bf16(o[4], o[5]); w.w = cvt_pk_bf16(o[6], o[7]);
                *(u32x4*)rowp = w; }
    }
};
template <class Epi, class Sched, bool ALIGN_EPI = false, bool SP2 = false>
__device__ __forceinline__ void gemm_phase(PG8_LAS unsigned char* lds, const Gemm g, const Sched& S, const Epi& E) {
    const int tid = threadIdx.x, wid = __builtin_amdgcn_readfirstlane(tid >> 6), lane = tid & 63, wr = wid >> 2, wc = wid & 3, fr = lane & 15, fq = lane >> 4;
    const int K = g.K, nt = K / BK;
    unsigned voffA[2], voffB[2];
#pragma unroll
    for (int i = 0; i < 2; ++i) { int R, C; stage_rc(tid * 16 + i * 8192, R, C); const int Rb = Epi::PERM ? ((R & ~31) + perm32(R & 31)) : R;
        voffA[i] = (unsigned)(R * K + C) * 2u; voffB[i] = (unsigned)(Rb * K + C) * 2u; }
    const size_t kstep = (size_t)(BK * 2);
    const size_t hstep = (size_t)HALF * K * 2;
    const unsigned ldsw = (unsigned)wid * 1024u;
    const int aoff = lds_byte(wr * 64 + fr, fq * 8), boff = lds_byte(wc * 32 + fr, fq * 8);
#define PG8_SA(b, h) (((b) * 2 + (h)) * HTB)
#define PG8_SB(b, h) ((4 + (b) * 2 + (h)) * HTB)
#define PG8_STAGE(bufoff, gbase, voff) do { _Pragma("unroll") for (int _i = 0; _i < 2; ++_i) \
        __builtin_amdgcn_global_load_lds((const unsigned*)((const char*)(gbase) + (voff)[_i]), (PG8_LAS unsigned*)(lds + (bufoff) + ldsw + _i * 8192), 16, 0, 0); } while (0)
#define PG8_LDA(dst, b, h) do { _Pragma("unroll") for (int m = 0; m < 4; ++m) _Pragma("unroll") for (int k = 0; k < 2; ++k) dst[m][k] = *(const PG8_LAS bf16x8*)(lds + PG8_SA(b, h) + aoff + m * 2048 + k * 1024); } while (0)
#define PG8_LDB(dst, b, h) do { _Pragma("unroll") for (int n = 0; n < 2; ++n) _Pragma("unroll") for (int k = 0; k < 2; ++k) dst[n][k] = *(const PG8_LAS bf16x8*)(lds + PG8_SB(b, h) + boff + n * 2048 + k * 1024); } while (0)
#define PG8_MMA(ai, bj, At, Bt) do { __builtin_amdgcn_s_setprio(1); _Pragma("unroll") for (int m = 0; m < 4; ++m) _Pragma("unroll") for (int n = 0; n < 2; ++n) _Pragma("unroll") for (int k = 0; k < 2; ++k) \
        acc[ai][bj][m][n] = __builtin_amdgcn_mfma_f32_16x16x32_bf16(Bt[n][k], At[m][k], acc[ai][bj][m][n], 0, 0, 0); __builtin_amdgcn_s_setprio(0); } while (0)
#define PG8_WAIT_V(n) asm volatile("s_waitcnt vmcnt(" #n ")" ::: "memory")
#define PG8_WAIT_L(n) asm volatile("s_waitcnt lgkmcnt(" #n ")" ::: "memory")
#define PG8_BAR __builtin_amdgcn_s_barrier()
#define PG8_SCHED __builtin_amdgcn_sched_barrier(0)
    Unit cur, nxt; int ui = 0;
    if (!S.next(0, cur)) return;
    f32x4 acc[2][2][4][2];
#pragma unroll
    for (int a = 0; a < 2; ++a)
#pragma unroll
        for (int b = 0; b < 2; ++b)
#pragma unroll
            for (int m = 0; m < 4; ++m)
#pragma unroll
                for (int n = 0; n < 2; ++n) acc[a][b][m][n] = (f32x4){0.f, 0.f, 0.f, 0.f};
    bf16x8 At[4][2], B0[2][2], B1[2][2];
    const char* cA = cur.a; const char* cB = cur.b;
    S.a_ready(cur);
    if constexpr (SP2) {
        PG8_STAGE(PG8_SB(0, 0), cB, voffB); PG8_STAGE(PG8_SB(0, 1), cB + hstep, voffB); PG8_STAGE(PG8_SA(0, 0), cA, voffA); PG8_STAGE(PG8_SA(0, 1), cA + hstep, voffA);
        if (wr == 1) PG8_BAR;
        PG8_WAIT_V(2); PG8_BAR;
        PG8_STAGE(PG8_SB(1, 0), cB + kstep, voffB); PG8_STAGE(PG8_SA(1, 0), cA + kstep, voffA); PG8_STAGE(PG8_SB(1, 1), cB + hstep + kstep, voffB);
        PG8_WAIT_V(6); PG8_BAR;
    } else {
        PG8_STAGE(PG8_SB(0, 0), cB, voffB); PG8_STAGE(PG8_SA(0, 0), cA, voffA); PG8_STAGE(PG8_SB(0, 1), cB + hstep, voffB); PG8_STAGE(PG8_SA(0, 1), cA + hstep, voffA);
        if (wr == 1) PG8_BAR;
        PG8_WAIT_V(4); PG8_BAR;
        PG8_STAGE(PG8_SB(1, 0), cB + kstep, voffB); PG8_STAGE(PG8_SA(1, 0), cA + kstep, voffA); PG8_STAGE(PG8_SB(1, 1), cB + hstep + kstep, voffB);
        PG8_WAIT_V(6); PG8_BAR;
    }
    for (;;) {
        const bool has_next = S.next(ui + 1, nxt);
        const char* nA = has_next ? nxt.a : cA; const char* nB = has_next ? nxt.b : cB;
        for (int t = 0; t < nt; t += 2) {
            const bool last = (t == nt - 2);
            const char* a1 = cA + (size_t)(t + 1) * kstep;
            const char* a2 = last ? nA : cA + (size_t)(t + 2) * kstep; const char* b2 = last ? nB : cB + (size_t)(t + 2) * kstep;
            const char* a3 = a2 + kstep; const char* b3 = b2 + kstep;
            if (last && has_next) S.a_ready(nxt);
            if constexpr (SP2) {
            PG8_LDB(B0, 0, 0); PG8_LDB(B1, 0, 1); PG8_SCHED; PG8_LDA(At, 0, 0); PG8_STAGE(PG8_SA(1, 1), a1 + hstep, voffA);
            PG8_WAIT_V(8); PG8_WAIT_L(0); PG8_BAR; PG8_MMA(0, 0, At, B0); PG8_MMA(0, 1, At, B1); PG8_BAR; PG8_SCHED;
            PG8_LDA(At, 0, 1); PG8_STAGE(PG8_SB(0, 0), b2, voffB); PG8_STAGE(PG8_SB(0, 1), b2 + hstep, voffB); PG8_STAGE(PG8_SA(0, 0), a2, voffA);
            PG8_WAIT_V(8); PG8_WAIT_L(0); PG8_BAR; PG8_MMA(1, 0, At, B0); PG8_MMA(1, 1, At, B1); PG8_BAR; PG8_SCHED;
            PG8_LDB(B0, 1, 0); PG8_LDB(B1, 1, 1); PG8_SCHED; PG8_LDA(At, 1, 0); PG8_STAGE(PG8_SA(0, 1), a2 + hstep, voffA);
            PG8_WAIT_V(8); PG8_WAIT_L(0); PG8_BAR; PG8_MMA(0, 0, At, B0); PG8_MMA(0, 1, At, B1); PG8_BAR; PG8_SCHED;
            PG8_LDA(At, 1, 1); PG8_STAGE(PG8_SB(1, 0), b3, voffB); PG8_STAGE(PG8_SB(1, 1), b3 + hstep, voffB); PG8_STAGE(PG8_SA(1, 0), a3, voffA);
            PG8_WAIT_V(8); PG8_WAIT_L(0); PG8_BAR; PG8_MMA(1, 0, At, B0); PG8_MMA(1, 1, At, B1); PG8_BAR; PG8_SCHED;
            } else {
            PG8_LDB(B0, 0, 0); PG8_SCHED; PG8_LDA(At, 0, 0); PG8_STAGE(PG8_SA(1, 1), a1 + hstep, voffA);
            PG8_WAIT_L(8); PG8_BAR; PG8_WAIT_L(0); PG8_MMA(0, 0, At, B0); PG8_BAR; PG8_SCHED;
            PG8_LDB(B1, 0, 1); PG8_STAGE(PG8_SB(0, 0), b2, voffB);
            PG8_BAR; PG8_WAIT_L(0); PG8_MMA(0, 1, At, B1); PG8_BAR;
            PG8_LDA(At, 0, 1); PG8_STAGE(PG8_SA(0, 0), a2, voffA);
            PG8_BAR; PG8_WAIT_L(0); PG8_MMA(1, 0, At, B0); PG8_BAR; PG8_SCHED;
            PG8_STAGE(PG8_SB(0, 1), b2 + hstep, voffB);
            PG8_WAIT_V(6); PG8_BAR; PG8_MMA(1, 1, At, B1); PG8_BAR;
            PG8_LDB(B0, 1, 0); PG8_SCHED; PG8_LDA(At, 1, 0); PG8_STAGE(PG8_SA(0, 1), a2 + hstep, voffA);
            PG8_WAIT_L(8); PG8_BAR; PG8_WAIT_L(0); PG8_MMA(0, 0, At, B0); PG8_BAR; PG8_SCHED;
            PG8_LDB(B1, 1, 1); PG8_STAGE(PG8_SB(1, 0), b3, voffB);
            PG8_BAR; PG8_WAIT_L(0); PG8_MMA(0, 1, At, B1); PG8_BAR;
            PG8_LDA(At, 1, 1); PG8_STAGE(PG8_SA(1, 0), a3, voffA);
            PG8_BAR; PG8_WAIT_L(0); PG8_MMA(1, 0, At, B0); PG8_BAR; PG8_SCHED;
            PG8_STAGE(PG8_SB(1, 1), b3 + hstep, voffB);
            PG8_WAIT_V(6); PG8_BAR; PG8_MMA(1, 1, At, B1); PG8_BAR;
            }
        }
        if constexpr (ALIGN_EPI) { if (wr == 0) PG8_BAR; }
        if constexpr (!Epi::AFTER_DRAIN) { E(acc, cur, wr, wc, fr, fq); S.done(cur); }
        if (!has_next) break;
#pragma unroll
        for (int a = 0; a < 2; ++a)
#pragma unroll
            for (int b = 0; b < 2; ++b)
#pragma unroll
                for (int m = 0; m < 4; ++m)
#pragma unroll
                    for (int n = 0; n < 2; ++n) acc[a][b][m][n] = (f32x4){0.f, 0.f, 0.f, 0.f};
        cur = nxt; cA = nA; cB = nB; ++ui;
        if constexpr (ALIGN_EPI) { if (wr == 1) PG8_BAR; }
    }
    PG8_WAIT_V(0);
    if constexpr (!ALIGN_EPI) { if (wr == 0) PG8_BAR; }
    PG8_BAR;
    if constexpr (Epi::AFTER_DRAIN) { E.fused(acc, cur, wr, wc, fr, fq, lds, wid, lane); S.done(cur); }
#undef PG8_SA
#undef PG8_SB
#undef PG8_STAGE
#undef PG8_LDA
#undef PG8_LDB
#undef PG8_MMA
#undef PG8_WAIT_V
#undef PG8_WAIT_L
#undef PG8_BAR
#undef PG8_SCHED
}
}
#define LAS __attribute__((address_space(3)))
#define GAS __attribute__((address_space(1)))
typedef unsigned v4u __attribute__((ext_vector_type(4)));
typedef float f32x4 __attribute__((ext_vector_type(4)));
constexpr int NWAVES = 8, NTHR = 512;
constexpr int LDS_BYTES = 163840;
constexpr int LDSCTL_OFF = LDS_BYTES - 1024, MISC_OFF = LDSCTL_OFF + 320;
constexpr int CW_CNT = 0;
constexpr int CW_BAR = 1024;
constexpr size_t CTL_ZERO_BYTES = 64 * 1024;

#define XB_TMO      128
#define XB_XCNT(j)  (256  + 64 * (j))
#define XB_XSUB(j)  (1280 + 64 * (j))
#define XB_XGEN(j)  (2304 + 64 * (j))
#define XB_TOP      3328
#define XB_TOPGEN   3392
#define XCD_BAR_WORDS 3456
#define XB_SPIN_CAP (1u << 18)
DEV unsigned xb_ld(unsigned* p)              { return __hip_atomic_load(p, __ATOMIC_RELAXED, __HIP_MEMORY_SCOPE_AGENT); }
DEV unsigned xb_add(unsigned* p, unsigned v) { return __hip_atomic_fetch_add(p, v, __ATOMIC_RELAXED, __HIP_MEMORY_SCOPE_AGENT); }
DEV unsigned xb_xcc_id() { return (unsigned)__builtin_amdgcn_s_getreg((3 << 11) | 20) & 0xFu; }
#define XB_SPIN(cond, bar) do { unsigned _sp = 0; while (cond) { __builtin_amdgcn_s_sleep(1); \
    if ((++_sp & 255u) == 0u) { if (xb_ld(&(bar)[XB_TMO])) break; if (_sp > XB_SPIN_CAP) { atomicAdd(&(bar)[XB_TMO], 1u); break; } } } } while (0)
struct XcdBarrier { unsigned* bar; unsigned x; volatile LAS unsigned* st; };
DEV XcdBarrier xcd_barrier_post(unsigned* bar, volatile LAS unsigned* st) {
    XcdBarrier b; b.bar = bar; b.x = xb_xcc_id(); b.st = st;
    if (threadIdx.x == 0) (void)xb_add(&bar[XB_XCNT(b.x)], 1u);
    return b;
}
DEV void xcd_barrier_complete(unsigned* bar, unsigned x, unsigned& nloc, unsigned& nx) {
    const unsigned G = gridDim.x * gridDim.y * gridDim.z;
    unsigned sum, cnt, mine, sp = 0u;
    for (;;) {
        sum = 0u; cnt = 0u; mine = 0u;
#pragma unroll
        for (unsigned j = 0; j < 16; ++j) { const unsigned c = xb_ld(&bar[XB_XCNT(j)]); sum += c; cnt += (c > 0u) ? 1u : 0u; mine = (j == x) ? c : mine; }
        if (sum == G) break;
        __builtin_amdgcn_s_sleep(1);
        if ((++sp & 255u) == 0u) { if (xb_ld(&bar[XB_TMO])) break; if (sp > XB_SPIN_CAP) { atomicAdd(&bar[XB_TMO], 1u); break; } }
    }
    nloc = mine > 0u ? mine : 1u; nx = cnt > 0u ? cnt : 1u;
}
DEV void xcd_barrier(const XcdBarrier& b) {
    asm volatile("s_waitcnt vmcnt(0)" ::: "memory");
    __syncthreads();
    if (threadIdx.x == 0) {
        unsigned* bar = b.bar;
        __builtin_amdgcn_s_waitcnt(0);
        unsigned nloc = b.st[0], nx = b.st[1];
        if (nloc == 0u) { xcd_barrier_complete(bar, b.x, nloc, nx); b.st[0] = nloc; b.st[1] = nx; }
        const unsigned old = xb_add(&bar[XB_XSUB(b.x)], 1u);
        const unsigned gen = old / nloc;
        if (old + 1u == (gen + 1u) * nloc) {
            __builtin_amdgcn_fence(__ATOMIC_RELEASE, "agent");
            asm volatile("s_waitcnt vmcnt(0)" ::: "memory");
            const unsigned og = xb_add(&bar[XB_TOP], 1u);
            const unsigned tg = og / nx;
            if (og + 1u == (tg + 1u) * nx) xb_add(&bar[XB_TOPGEN], 1u);
            else XB_SPIN(xb_ld(&bar[XB_TOPGEN]) == tg, bar);
            __builtin_amdgcn_fence(__ATOMIC_ACQUIRE, "agent");
            xb_add(&bar[XB_XGEN(b.x)], 1u);
            asm volatile("s_waitcnt vmcnt(0)" ::: "memory");
        } else {
            XB_SPIN(xb_ld(&bar[XB_XGEN(b.x)]) == gen, bar);
            __builtin_amdgcn_fence(__ATOMIC_ACQUIRE, "agent");
            asm volatile("s_waitcnt vmcnt(0)" ::: "memory");
        }
    }
    __syncthreads();
}

DEV void transpose_item(const float* W, int N, int k0, int n0, bf16* dst, int ldk, LAS float* scr, int lane) {
#pragma unroll 8
    for (int i = 0; i < 32; ++i) { const int kk = 2 * i + (lane >> 5); scr[kk * 33 + (lane & 31)] = W[(size_t)(k0 + kk) * N + n0 + (lane & 31)]; }
    asm volatile("s_waitcnt lgkmcnt(0)" ::: "memory");
    const int c = lane & 7;
#pragma unroll
    for (int j = 0; j < 4; ++j) { const int n = (lane >> 3) + 8 * j; const LAS float* s = scr + (8 * c) * 33 + n;
        v4u o; o.x = pk2(s[0 * 33], s[1 * 33]); o.y = pk2(s[2 * 33], s[3 * 33]); o.z = pk2(s[4 * 33], s[5 * 33]); o.w = pk2(s[6 * 33], s[7 * 33]);
        *(v4u*)(dst + (size_t)n * ldk + k0 + 8 * c) = o; }
    asm volatile("s_waitcnt lgkmcnt(0)" ::: "memory");
}
DEV void ph_prep1(const float* w_in, const float* w_out, const float* rgw, const float* rew, const float* w_up, const float* a_up, const float* g_up, bf16* win_t, bf16* wout_t, float* wrt, bf16* lora, LAS float* scr, int gw, int NGW, int lane) {
    for (int i = gw * 64 + lane; i < 512 * 256; i += NGW * 64) { const int c = i >> 8, j = i & 255;
        if (j < 64) lora[c * 64 + j] = (bf16)f2bf(w_up[j * DR + c]); else if (j < 128) lora[512 * 64 + c * 64 + (j - 64)] = (bf16)f2bf(a_up[(j - 64) * DR + c]); else lora[2 * 512 * 64 + c * 128 + (j - 128)] = (bf16)f2bf(g_up[(j - 128) * DR + c]); }
    constexpr int I_IN = (D / 64) * (DIN / 32), I_OUT = (D / 64) * (D / 32);
    for (int it = gw; it < I_IN + I_OUT; it += NGW) {
        if (it < I_IN) { const int nblk = DIN / 32, kb = it / nblk, nb = it % nblk; transpose_item(w_in, DIN, 64 * kb, 32 * nb, win_t + (size_t)(32 * nb) * D, D, scr, lane); }
        else { const int r = it - I_IN, nblk = D / 32, kb = r / nblk, nb = r % nblk; transpose_item(w_out, D, 64 * kb, 32 * nb, wout_t + (size_t)(32 * nb) * D, D, scr, lane); }
    }
    for (int i = gw * 64 + lane; i < 36 * 1024; i += NGW * 64) { const int e = i >> 10, d = i & 1023; wrt[i] = e < 4 ? rgw[d * 4 + e] : rew[d * 32 + (e - 4)]; }
}
DEV void ph_prep2(const float* wg, const float* wu, const float* wd, bf16* wgu_t, bf16* wd_t, LAS float* scr, int gw, int NGW, int lane) {
    constexpr int I_G = (D / 64) * (DE / 32), I_D = (DE / 64) * (D / 32), PER_E = 2 * I_G + I_D;
    for (int it = gw; it < NE * PER_E; it += NGW) {
        const int e = it / PER_E; int r = it % PER_E;
        if (r < 2 * I_G) { const int up = r >= I_G; if (up) r -= I_G; const int nblk = DE / 32, kb = r / nblk, nb = r % nblk, n0 = 32 * nb;
            const float* W = (up ? wu : wg) + (size_t)e * D * DE;
            bf16* dst = wgu_t + ((size_t)e * 1024 + (n0 >> 7) * 256 + up * 128 + (n0 & 127)) * D;
            transpose_item(W, DE, 64 * kb, n0, dst, D, scr, lane); }
        else { r -= 2 * I_G; const int nblk = D / 32, kb = r / nblk, nb = r % nblk, n0 = 32 * nb;
            transpose_item(wd + (size_t)e * DE * D, D, 64 * kb, n0, wd_t + ((size_t)e * D + n0) * DE, DE, scr, lane); }
    }
}
DEV void ph_rmsnorm(const float* x, const float* g, bf16* out, int gw, int NGW, int lane) {
    for (int row = gw; row < T; row += NGW) {
        const f32x4* xr = (const f32x4*)(x + (size_t)row * D) + lane; const f32x4* gr = (const f32x4*)g + lane;
        f32x4 v[4]; float s = 0.f;
#pragma unroll
        for (int j = 0; j < 4; ++j) { v[j] = xr[64 * j]; s += (v[j].x * v[j].x + v[j].y * v[j].y) + (v[j].z * v[j].z + v[j].w * v[j].w); }
        const float rstd = rsqrtf(wave_sum(s) * (1.f / D) + RMS_EPS);
        unsigned long long* o8 = (unsigned long long*)(out + (size_t)row * D) + lane;
#pragma unroll
        for (int j = 0; j < 4; ++j) { const f32x4 gg = gr[64 * j]; o8[64 * j] = (unsigned long long)pk2(v[j].x * rstd * gg.x, v[j].y * rstd * gg.y) | ((unsigned long long)pk2(v[j].z * rstd * gg.z, v[j].w * rstd * gg.w) << 32); }
    }
}

typedef short bf16x8 __attribute__((ext_vector_type(8)));
typedef short bf16x4 __attribute__((ext_vector_type(4)));
typedef unsigned u32x2 __attribute__((ext_vector_type(2)));
DEV f32x4 mfma16(bf16x8 f, bf16x8 g, f32x4 c) { return __builtin_amdgcn_mfma_f32_16x16x32_bf16(f, g, c, 0, 0, 0); }
DEV unsigned cvtpk(float lo, float hi) { return cvt_pk_bf16(lo, hi); }
DEV bf16x8 ldfrag(const LAS unsigned char* base, int row, int stride, int kbyte) { return *(const LAS bf16x8*)(base + row * stride + kbyte); }
constexpr int SA64 = 144, SA128 = 272;
constexpr int CH = 64, NCH = SEQ / CH;

constexpr int HU_UT = 0, HU_QH = 32768, HU_OT = 49152, HU_BYTES = 65536;
constexpr int HL_QT = 0, HL_KT = 17408, HL_KHT = 34816, HL_VT = 53248, HL_SC = 71680, HL_PFX = 80896;
DEV void hgrn_unitA(int unit, const bf16* p, const float* cw, const float* lbl, unsigned char* iah, float* dch, bf16* mix, LAS unsigned char* lds, int tid) {
    const int c = unit & 31, h = (unit >> 5) & 3, b = unit >> 7;
    const int lane = tid & 63, wave = tid >> 6, q16 = lane & 15, g4 = lane >> 4;
    const size_t trow0 = (size_t)b * SEQ + (size_t)c * CH;
    unsigned char* uo = iah + (size_t)unit * HU_BYTES;
    LAS float* pfx = (LAS float*)(lds + HL_PFX);
    const int cc = tid & 15, run = tid >> 4, c0 = 8 * cc, tl = 2 * run;
    float qv[2][8], lfv[2][8], khv[2][8];
    {
        v4u rq[5], rf[5];
#pragma unroll
        for (int i = 0; i < 5; ++i) { const int sl = c * CH + tl - 3 + i;
            if (sl >= 0) { const bf16* row = p + (trow0 + tl - 3 + i) * DIN + DRIN + h * 128 + c0; rq[i] = *(const v4u*)row; rf[i] = *(const v4u*)(row + 512); }
            else { rq[i] = (v4u){0u, 0u, 0u, 0u}; rf[i] = (v4u){0u, 0u, 0u, 0u}; } }
#pragma unroll
        for (int e = 0; e < 8; ++e) {
            const int col = h * 128 + c0 + e;
            float wq[4], wf[4];
#pragma unroll
            for (int j = 0; j < 4; ++j) { wq[j] = cw[j * 1536 + col]; wf[j] = cw[j * 1536 + 512 + col]; }
            const float lb = 1.f / (1.f + __expf(lbl[512 + col] - lbl[col]));
            float xq[5], xf[5];
#pragma unroll
            for (int i = 0; i < 5; ++i) { const unsigned wq_ = rq[i][e >> 1], wf_ = rf[i][e >> 1];
                xq[i] = (e & 1) ? __uint_as_float(wq_ & 0xffff0000u) : __uint_as_float(wq_ << 16);
                xf[i] = (e & 1) ? __uint_as_float(wf_ & 0xffff0000u) : __uint_as_float(wf_ << 16); }
#pragma unroll
            for (int tt = 0; tt < 2; ++tt) {
                const float aq = wq[0] * xq[tt] + wq[1] * xq[tt + 1] + wq[2] * xq[tt + 2] + wq[3] * xq[tt + 3];
                const float af = wf[0] * xf[tt] + wf[1] * xf[tt + 1] + wf[2] * xf[tt + 2] + wf[3] * xf[tt + 3];
                const float fg = lb + (1.f - lb) * sigmoidf_(af);
                qv[tt][e] = aq * sigmoidf_(aq); lfv[tt][e] = __logf(fg); khv[tt][e] = 1.f - fg; }
            pfx[run * 128 + c0 + e] = lfv[0][e] + lfv[1][e];
        }
    }
    __syncthreads();
    if (tid < 128) { float a = 0.f;
#pragma unroll 8
        for (int r = 0; r < 32; ++r) { const float v = pfx[r * 128 + tid]; pfx[r * 128 + tid] = a; a += v; }
        pfx[32 * 128 + tid] = a; }
    __syncthreads();
    {
        unsigned qt[2][4], kt[2][4], qh[2][4];
#pragma unroll
        for (int e = 0; e < 8; ++e) {
            const int k = c0 + e;
            const float base = pfx[run * 128 + k], ref = pfx[16 * 128 + k], tot = pfx[32 * 128 + k];
            const float eref = __expf(ref), etr = __expf(tot - ref);
            float val_qt[2], val_kt[2], val_qh[2], val_kh[2];
            float bc = base;
#pragma unroll
            for (int tt = 0; tt < 2; ++tt) { bc += lfv[tt][e]; const float E = __expf(bc - ref), Ei = __builtin_amdgcn_rcpf(E);
                val_qt[tt] = qv[tt][e] * E; val_kt[tt] = khv[tt][e] * Ei; val_qh[tt] = val_qt[tt] * eref; val_kh[tt] = val_kt[tt] * etr; }
            *(LAS unsigned*)(lds + HL_KHT + k * SA64 + tl * 2) = cvtpk(val_kh[0], val_kh[1]);
            if (e & 1) {
#pragma unroll
                for (int tt = 0; tt < 2; ++tt) { qt[tt][e >> 1] = (qt[tt][e >> 1] & 0xffffu) | (f2bf(val_qt[tt]) << 16); kt[tt][e >> 1] = (kt[tt][e >> 1] & 0xffffu) | (f2bf(val_kt[tt]) << 16); qh[tt][e >> 1] = (qh[tt][e >> 1] & 0xffffu) | (f2bf(val_qh[tt]) << 16); }
            } else {
#pragma unroll
                for (int tt = 0; tt < 2; ++tt) { qt[tt][e >> 1] = f2bf(val_qt[tt]); kt[tt][e >> 1] = f2bf(val_kt[tt]); qh[tt][e >> 1] = f2bf(val_qh[tt]); }
            }
            if (run == 0) dch[(size_t)unit * 128 + k] = __expf(tot);
        }
#pragma unroll
        for (int tt = 0; tt < 2; ++tt) {
            *(LAS v4u*)(lds + HL_QT + (tl + tt) * SA128 + c0 * 2) = (v4u){qt[tt][0], qt[tt][1], qt[tt][2], qt[tt][3]};
            *(LAS v4u*)(lds + HL_KT + (tl + tt) * SA128 + c0 * 2) = (v4u){kt[tt][0], kt[tt][1], kt[tt][2], kt[tt][3]};
            *(v4u*)(uo + HU_QH + (tl + tt) * 256 + c0 * 2) = (v4u){qh[tt][0], qh[tt][1], qh[tt][2], qh[tt][3]};
        }
    }
    {
        v4u ri[5];
#pragma unroll
        for (int i = 0; i < 5; ++i) { const int sl = c * CH + tl - 3 + i;
            if (sl >= 0) ri[i] = *(const v4u*)(p + (trow0 + tl - 3 + i) * DIN + DRIN + 1024 + h * 128 + c0); else ri[i] = (v4u){0u, 0u, 0u, 0u}; }
#pragma unroll
        for (int e = 0; e < 8; ++e) {
            const int col = h * 128 + c0 + e;
            float wi[4], xi[5];
#pragma unroll
            for (int j = 0; j < 4; ++j) wi[j] = cw[j * 1536 + 1024 + col];
#pragma unroll
            for (int i = 0; i < 5; ++i) { const unsigned w_ = ri[i][e >> 1]; xi[i] = (e & 1) ? __uint_as_float(w_ & 0xffff0000u) : __uint_as_float(w_ << 16); }
            const float v0 = wi[0] * xi[0] + wi[1] * xi[1] + wi[2] * xi[2] + wi[3] * xi[3], v1 = wi[0] * xi[1] + wi[1] * xi[2] + wi[2] * xi[3] + wi[3] * xi[4];
            *(LAS unsigned*)(lds + HL_VT + (c0 + e) * SA64 + tl * 2) = cvtpk(v0, v1);
        }
#pragma unroll
        for (int tt = 0; tt < 2; ++tt) { const v4u gr = *(const v4u*)(p + (trow0 + tl + tt) * DIN + DRIN + 1536 + h * 128 + c0); unsigned o[4];
#pragma unroll
            for (int e2 = 0; e2 < 4; ++e2) { const float g0 = __uint_as_float(gr[e2] << 16), g1 = __uint_as_float(gr[e2] & 0xffff0000u); o[e2] = cvtpk(g0 * sigmoidf_(g0), g1 * sigmoidf_(g1)); }
            *(v4u*)(mix + (trow0 + tl + tt) * D + 512 + h * 128 + c0) = (v4u){o[0], o[1], o[2], o[3]}; }
    }
    __syncthreads();
    for (int ti = wave; ti < 16; ti += 8) {
        const int mt = ti >> 2, nt = ti & 3;
        f32x4 acc = (f32x4){0.f, 0.f, 0.f, 0.f};
        if (nt <= mt) {
#pragma unroll
            for (int ks = 0; ks < 4; ++ks) acc = mfma16(ldfrag(lds + HL_KT, 16 * nt + q16, SA128, ks * 64 + g4 * 16), ldfrag(lds + HL_QT, 16 * mt + q16, SA128, ks * 64 + g4 * 16), acc);
            if (nt == mt) {
#pragma unroll
                for (int r = 0; r < 4; ++r) if (4 * g4 + r > q16) acc[r] = 0.f; }
        }
        *(LAS u32x2*)(lds + HL_SC + (16 * mt + q16) * SA64 + (16 * nt + 4 * g4) * 2) = (u32x2){cvtpk(acc[0], acc[1]), cvtpk(acc[2], acc[3])};
    }
    __syncthreads();
    {
        const int vrow = 16 * wave + q16;
        const bf16x8 vf0 = ldfrag(lds + HL_VT, vrow, SA64, g4 * 16), vf1 = ldfrag(lds + HL_VT, vrow, SA64, 64 + g4 * 16);
#pragma unroll
        for (int mt = 0; mt < 4; ++mt) {
            f32x4 acc = (f32x4){0.f, 0.f, 0.f, 0.f};
            acc = mfma16(ldfrag(lds + HL_SC, 16 * mt + q16, SA64, g4 * 16), vf0, acc);
            acc = mfma16(ldfrag(lds + HL_SC, 16 * mt + q16, SA64, 64 + g4 * 16), vf1, acc);
            *(u32x2*)(uo + HU_OT + vrow * 128 + (16 * mt + 4 * g4) * 2) = (u32x2){cvtpk(acc[0], acc[1]), cvtpk(acc[2], acc[3])};
        }
#pragma unroll
        for (int kt = 0; kt < 8; ++kt) {
            f32x4 acc = (f32x4){0.f, 0.f, 0.f, 0.f};
            acc = mfma16(ldfrag(lds + HL_KHT, 16 * kt + q16, SA64, g4 * 16), vf0, acc);
            acc = mfma16(ldfrag(lds + HL_KHT, 16 * kt + q16, SA64, 64 + g4 * 16), vf1, acc);
            *(u32x2*)(uo + HU_UT + vrow * 256 + (16 * kt + 4 * g4) * 2) = (u32x2){cvtpk(acc[0], acc[1]), cvtpk(acc[2], acc[3])};
        }
    }
    __syncthreads();
}

DEV void hgrn_seqB(int bh, const unsigned char* iah, const float* dch, const float* ng, bf16* mix, LAS float* red, int tid) {
    const int lane = tid & 63, wave = tid >> 6, q16 = lane & 15, g4 = lane >> 4;
    const int h = bh & 3, b = bh >> 2, v = 16 * wave + q16;
    const float gain = ng[h * 128 + v];
    f32x4 S[8];
#pragma unroll
    for (int i = 0; i < 8; ++i) S[i] = (f32x4){0.f, 0.f, 0.f, 0.f};
    for (int c = 0; c < NCH; ++c) {
        const unsigned char* ui = iah + (size_t)(bh * NCH + c) * HU_BYTES;
        const size_t trow0 = (size_t)b * SEQ + (size_t)c * CH;
        bf16x8 sb[4];
#pragma unroll
        for (int ks = 0; ks < 4; ++ks) { const unsigned w0 = cvtpk(S[2 * ks][0], S[2 * ks][1]), w1 = cvtpk(S[2 * ks][2], S[2 * ks][3]), w2 = cvtpk(S[2 * ks + 1][0], S[2 * ks + 1][1]), w3 = cvtpk(S[2 * ks + 1][2], S[2 * ks + 1][3]);
            const v4u t4 = (v4u){w0, w1, w2, w3}; sb[ks] = __builtin_bit_cast(bf16x8, t4); }
        f32x4 o[4];
#pragma unroll
        for (int mt = 0; mt < 4; ++mt) {
            const u32x2 oi = *(const u32x2*)(ui + HU_OT + v * 128 + (16 * mt + 4 * g4) * 2);
            f32x4 acc = (f32x4){__uint_as_float(oi.x << 16), __uint_as_float(oi.x & 0xffff0000u), __uint_as_float(oi.y << 16), __uint_as_float(oi.y & 0xffff0000u)};
#pragma unroll
            for (int ks = 0; ks < 4; ++ks) {
                const unsigned char* qrow = ui + HU_QH + (16 * mt + q16) * 256 + ks * 64;
                const u32x2 a0 = *(const u32x2*)(qrow + g4 * 8), a1 = *(const u32x2*)(qrow + 32 + g4 * 8);
                const v4u a4 = (v4u){a0.x, a0.y, a1.x, a1.y};
                acc = mfma16(__builtin_bit_cast(bf16x8, a4), sb[ks], acc);
            }
            o[mt] = acc;
        }
#pragma unroll
        for (int i = 0; i < 8; ++i) {
            const f32x4 d = *(const f32x4*)(dch + (size_t)(bh * NCH + c) * 128 + 16 * i + 4 * g4);
            const u32x2 uu = *(const u32x2*)(ui + HU_UT + v * 256 + (16 * i + 4 * g4) * 2);
            S[i][0] = S[i][0] * d[0] + __uint_as_float(uu.x << 16); S[i][1] = S[i][1] * d[1] + __uint_as_float(uu.x & 0xffff0000u);
            S[i][2] = S[i][2] * d[2] + __uint_as_float(uu.y << 16); S[i][3] = S[i][3] * d[3] + __uint_as_float(uu.y & 0xffff0000u);
        }
        float ss[4][4];
#pragma unroll
        for (int mt = 0; mt < 4; ++mt)
#pragma unroll
            for (int r = 0; r < 4; ++r) { float s = o[mt][r] * o[mt][r]; s += __shfl_xor(s, 1); s += __shfl_xor(s, 2); s += __shfl_xor(s, 4); s += __shfl_xor(s, 8); ss[mt][r] = s; }
        __syncthreads();
        if (q16 == 0) {
#pragma unroll
            for (int mt = 0; mt < 4; ++mt)
#pragma unroll
                for (int r = 0; r < 4; ++r) red[(16 * mt + 4 * g4 + r) * 8 + wave] = ss[mt][r]; }
        __syncthreads();
#pragma unroll
        for (int mt = 0; mt < 4; ++mt)
#pragma unroll
            for (int r = 0; r < 4; ++r) { const int t = 16 * mt + 4 * g4 + r;
                const LAS f32x4* rp = (const LAS f32x4*)(red + t * 8); const f32x4 r0 = rp[0], r1 = rp[1];
                const float ms = ((r0[0] + r0[1]) + (r0[2] + r0[3]) + (r1[0] + r1[1]) + (r1[2] + r1[3])) * (1.f / 128.f);
                const float gate = bf2f(mix[(trow0 + t) * D + 512 + h * 128 + v]);
                mix[(trow0 + t) * D + 512 + h * 128 + v] = (bf16)f2bf(o[mt][r] * rsqrtf(ms + RMS_EPS) * gain * gate); }
    }
}
constexpr int RU_L = 0, RU_RM = 8192, RU_NT = 16384, RU_YT = 24576, RU_BYTES = 32768;
constexpr int RL_TDW = 0, RL_DA = 9216, RL_SDG = 18432;
constexpr int RL_A = 0, RL_CUM = 17408;
constexpr int RL_AAK = 0, RL_ARB = 9216, RL_ARK = 18432;
constexpr int RL_RAW = 36864, RAW_STRIDE = 400;
constexpr int RL_X2 = 36864;
constexpr int RL_AAB = 62976;
constexpr int RL_AT = 79360, RL_BT = 88576, RL_KT = 97792, RL_RT = 107008;
constexpr int RL_WT = RL_BT, RL_UT = RL_KT;
constexpr int RL_BHT = 116224, RL_KHT = 125440, RL_VT = 134656;
constexpr int RL_SEG = 143872;
constexpr int FS = 272;

DEV float bflo(unsigned w) { return __uint_as_float(w << 16); }
DEV float bfhi(unsigned w) { return __uint_as_float(w & 0xffff0000u); }

constexpr int RL_ULDS = 145920;
DEV void sub_solve(LAS unsigned char* lds, int lane, int wave) {
    LAS unsigned char* pu = lds + (wave == 0 ? RL_ULDS : RL_X2) + lane * 4; const int us = wave == 0 ? 256 : FS;
    LAS unsigned char* pw = lds + (wave == 0 ? RL_WT : RL_UT) + lane * SA64;
#pragma nounroll
    for (int I = 0; I < 8; ++I) {
        LAS unsigned char* pa = lds + RL_AAB + 8 * I * 256;
        float xa[8];
        if (wave == 0) {
#pragma unroll
            for (int r = 0; r < 8; ++r) xa[r] = bf2f(*(const LAS bf16*)(lds + RL_AT + (8 * I + r) * SA64 + lane * 2));
        } else {
#pragma unroll
            for (int r = 0; r < 8; ++r) xa[r] = *(const LAS float*)(lds + RL_X2 + (8 * I + r) * FS + lane * 4);
        }
#pragma nounroll
        for (int J = 0; J < I; ++J) {
            float uj[8];
#pragma unroll
            for (int s2 = 0; s2 < 8; ++s2) uj[s2] = *(const LAS float*)(pu + (8 * J + s2) * us);
#pragma unroll
            for (int r = 0; r < 8; ++r)
#pragma unroll
                for (int s4 = 0; s4 < 2; ++s4) { const f32x4 a4 = *(const LAS f32x4*)(pa + r * 256 + (8 * J + 4 * s4) * 4);
                    xa[r] += a4[0] * uj[4 * s4] + a4[1] * uj[4 * s4 + 1] + a4[2] * uj[4 * s4 + 2] + a4[3] * uj[4 * s4 + 3]; }
        }
        const LAS unsigned char* pd = pa + 8 * I * 4;
#pragma unroll
        for (int r = 1; r < 8; ++r)
#pragma unroll
            for (int s4 = 0; s4 < 2; ++s4) if (4 * s4 < r) { const f32x4 a4 = *(const LAS f32x4*)(pd + r * 256 + s4 * 16);
#pragma unroll
                for (int e = 0; e < 4; ++e) if (4 * s4 + e < r) xa[r] += a4[e] * xa[4 * s4 + e]; }
#pragma unroll
        for (int r = 0; r < 8; ++r) *(LAS float*)(pu + (8 * I + r) * us) = xa[r];
        *(LAS v4u*)(pw + I * 16) = (v4u){cvt_pk_bf16(xa[0], xa[1]), cvt_pk_bf16(xa[2], xa[3]), cvt_pk_bf16(xa[4], xa[5]), cvt_pk_bf16(xa[6], xa[7])};
    }
}

DEV void rwkv_unitA(int unit, const bf16* p, const float* mu, const float* w0, const float* a0, const float* k_k, const float* k_a, const float* r_k,
                    const bf16* wupT, const bf16* aupT, const bf16* gupT, unsigned char* iar, float* gcr, bf16* g_r, float* bonus, bf16* mix, LAS unsigned char* lds, int tid0) {
    const int c = unit & 31, h = (unit >> 5) & 7, b = unit >> 8;
    const size_t trow0 = (size_t)b * SEQ + (size_t)c * CH;
    unsigned char* uo = iar + (size_t)unit * RU_BYTES;
    { int tid = tid0; asm volatile("" : "+v"(tid)); const int lane = tid & 63, wave = __builtin_amdgcn_readfirstlane(tid >> 6), q16 = lane & 15, g4 = lane >> 4; (void)lane; (void)wave; (void)q16; (void)g4;
    for (int it = tid; it < 65 * 24; it += NTHR) { const int row = it / 24, ch8 = it % 24, part = ch8 >> 3, cc = ch8 & 7;
        v4u val = (v4u){0u, 0u, 0u, 0u};
        if (row > 0 || c > 0) val = *(const v4u*)(p + (trow0 + row - 1) * DIN + part * 512 + h * 64 + cc * 8);
        *(LAS v4u*)(lds + RL_RAW + row * RAW_STRIDE + ch8 * 16) = val; }
    for (int it = tid; it < 64 * 32; it += NTHR) { const int t = it >> 5, ch8 = it & 31;
        const bf16* src = p + (trow0 + t) * DIN + 1536 + ch8 * 8;
        const v4u cur = *(const v4u*)src; v4u prv = (v4u){0u, 0u, 0u, 0u};
        if (t > 0 || c > 0) prv = *(const v4u*)(src - DIN);
        unsigned o[4];
#pragma unroll
        for (int e2 = 0; e2 < 4; ++e2) { const int col = 1536 + ch8 * 8 + 2 * e2;
            float x0 = bflo(cur[e2]), x1 = bfhi(cur[e2]); x0 += mu[col] * (bflo(prv[e2]) - x0); x1 += mu[col + 1] * (bfhi(prv[e2]) - x1);
            if (ch8 < 8) { x0 = tanhf(x0); x1 = tanhf(x1); } else if (ch8 >= 16) { x0 = sigmoidf_(x0); x1 = sigmoidf_(x1); }
            o[e2] = cvt_pk_bf16(x0, x1); }
        LAS unsigned char* dst = ch8 < 8 ? lds + RL_TDW + t * SA64 + ch8 * 16 : (ch8 < 16 ? lds + RL_DA + t * SA64 + (ch8 - 8) * 16 : lds + RL_SDG + t * SA128 + (ch8 - 16) * 16);
        *(LAS v4u*)dst = (v4u){o[0], o[1], o[2], o[3]}; }
    __syncthreads();
    }
    { int tid = tid0; asm volatile("" : "+v"(tid)); const int lane = tid & 63, wave = __builtin_amdgcn_readfirstlane(tid >> 6), q16 = lane & 15, g4 = lane >> 4; (void)lane; (void)wave; (void)q16; (void)g4;
    {
        const int mt = wave >> 1;
        f32x4 zw[2], za[2], zg[2];
#pragma unroll
        for (int j = 0; j < 2; ++j) { const int nt = 2 * (wave & 1) + j; const int chrow = h * 64 + 16 * nt + q16;
            f32x4 aw = (f32x4){0.f, 0.f, 0.f, 0.f}, aa = aw, ag = aw;
#pragma unroll
            for (int ks = 0; ks < 2; ++ks) {
                aw = mfma16(*(const bf16x8*)(wupT + chrow * 64 + ks * 32 + g4 * 8), ldfrag(lds + RL_TDW, 16 * mt + q16, SA64, ks * 64 + g4 * 16), aw);
                aa = mfma16(*(const bf16x8*)(aupT + chrow * 64 + ks * 32 + g4 * 8), ldfrag(lds + RL_DA, 16 * mt + q16, SA64, ks * 64 + g4 * 16), aa); }
#pragma unroll
            for (int ks = 0; ks < 4; ++ks) ag = mfma16(*(const bf16x8*)(gupT + chrow * 128 + ks * 32 + g4 * 8), ldfrag(lds + RL_SDG, 16 * mt + q16, SA128, ks * 64 + g4 * 16), ag);
            zw[j] = aw; za[j] = aa; zg[j] = ag; }
        __syncthreads();
#pragma unroll
        for (int j = 0; j < 2; ++j) { const int nt = 2 * (wave & 1) + j, t = 16 * mt + q16, ch = 16 * nt + 4 * g4;
            const f32x4 w0v = *(const f32x4*)(w0 + h * 64 + ch), a0v = *(const f32x4*)(a0 + h * 64 + ch);
            f32x4 ldv, av;
#pragma unroll
            for (int r = 0; r < 4; ++r) { const float nz = -(zw[j][r] + w0v[r]), sp = fmaxf(nz, 0.f) + log1pf(__expf(-fabsf(nz)));
                ldv[r] = -__expf(-sp - 0.5f); av[r] = sigmoidf_(za[j][r] + a0v[r]); }
            *(LAS f32x4*)(lds + RL_CUM + t * FS + ch * 4) = ldv; *(LAS f32x4*)(lds + RL_A + t * FS + ch * 4) = av;
            *(u32x2*)(g_r + (trow0 + t) * DR + h * 64 + ch) = (u32x2){cvt_pk_bf16(zg[j][0], zg[j][1]), cvt_pk_bf16(zg[j][2], zg[j][3])}; }
    }
    __syncthreads();
    }
    { int tid = tid0; asm volatile("" : "+v"(tid)); const int lane = tid & 63, wave = __builtin_amdgcn_readfirstlane(tid >> 6), q16 = lane & 15, g4 = lane >> 4; (void)lane; (void)wave; (void)q16; (void)g4;
    {
        const int ch = tid & 63, seg = tid >> 6; LAS float* segt = (LAS float*)(lds + RL_SEG);
        float loc[8]; float a = 0.f;
#pragma unroll
        for (int i = 0; i < 8; ++i) { a += *(LAS float*)(lds + RL_CUM + (8 * seg + i) * FS + ch * 4); loc[i] = a; }
        segt[seg * 64 + ch] = a;
        __syncthreads();
        float off = 0.f;
#pragma unroll
        for (int s2 = 0; s2 < 7; ++s2) if (s2 < seg) off += segt[s2 * 64 + ch];
#pragma unroll
        for (int i = 0; i < 8; ++i) *(LAS float*)(lds + RL_CUM + (8 * seg + i) * FS + ch * 4) = loc[i] + off;
    }
    __syncthreads();
    }
    { int tid = tid0; asm volatile("" : "+v"(tid)); const int lane = tid & 63, wave = __builtin_amdgcn_readfirstlane(tid >> 6), q16 = lane & 15, g4 = lane >> 4; (void)lane; (void)wave; (void)q16; (void)g4;
    {
        const int t = tid >> 3, ch0 = 8 * (tid & 7);
        const LAS unsigned char* rawc = lds + RL_RAW + (t + 1) * RAW_STRIDE, *rawp = lds + RL_RAW + t * RAW_STRIDE;
        float xr[8], xk[8], xv[8];
#pragma unroll
        for (int part = 0; part < 3; ++part) { const v4u cu = *(const LAS v4u*)(rawc + part * 128 + ch0 * 2), pv = *(const LAS v4u*)(rawp + part * 128 + ch0 * 2);
#pragma unroll
            for (int e2 = 0; e2 < 4; ++e2) { const int col = part * 512 + h * 64 + ch0 + 2 * e2;
                float x0 = bflo(cu[e2]), x1 = bfhi(cu[e2]); x0 += mu[col] * (bflo(pv[e2]) - x0); x1 += mu[col + 1] * (bfhi(pv[e2]) - x1);
                if (part == 0) { xr[2 * e2] = x0; xr[2 * e2 + 1] = x1; } else if (part == 1) { xk[2 * e2] = x0; xk[2 * e2 + 1] = x1; } else { xv[2 * e2] = x0; xv[2 * e2 + 1] = x1; } } }
        float kkp[8], ssq = 0.f;
#pragma unroll
        for (int e = 0; e < 8; ++e) { kkp[e] = xk[e] * k_k[h * 64 + ch0 + e]; ssq += kkp[e] * kkp[e]; }
        ssq += __shfl_xor(ssq, 1); ssq += __shfl_xor(ssq, 2); ssq += __shfl_xor(ssq, 4);
        const float inv = 1.f / fmaxf(sqrtf(ssq), L2_EPS);
        float bon = 0.f;
        unsigned oa[4], ob[4], ok[4], orr[4];
        float bh[8], kh[8];
#pragma unroll
        for (int e = 0; e < 8; ++e) { const int ch = ch0 + e;
            const float a = *(const LAS float*)(lds + RL_A + t * FS + ch * 4), cumt = *(const LAS float*)(lds + RL_CUM + t * FS + ch * 4);
            const float cump = t > 0 ? *(const LAS float*)(lds + RL_CUM + (t - 1) * FS + ch * 4) : 0.f, cumC = *(const LAS float*)(lds + RL_CUM + 63 * FS + ch * 4);
            const float kk = kkp[e] * inv, kp = xk[e] * (1.f + (a - 1.f) * k_a[h * 64 + ch]), bb = kk * a;
            const float E = __expf(cumt), Ei = __builtin_amdgcn_rcpf(E), Ep = __expf(cump), EC = __expf(cumC - cumt);
            const float vat = -kk * Ep, vbt = bb * Ei, vkt = kp * Ei, vrt = xr[e] * E;
            bh[e] = bb * EC; kh[e] = kp * EC;
            bon += xr[e] * kp * r_k[h * 64 + ch];
            if (e & 1) { oa[e >> 1] |= f2bf(vat) << 16; ob[e >> 1] |= f2bf(vbt) << 16; ok[e >> 1] |= f2bf(vkt) << 16; orr[e >> 1] |= f2bf(vrt) << 16; }
            else { oa[e >> 1] = f2bf(vat); ob[e >> 1] = f2bf(vbt); ok[e >> 1] = f2bf(vkt); orr[e >> 1] = f2bf(vrt); }
            if (t == 63) gcr[(size_t)unit * 64 + ch] = E;
        }
        *(LAS v4u*)(lds + RL_AT + t * SA64 + ch0 * 2) = (v4u){oa[0], oa[1], oa[2], oa[3]};
        *(LAS v4u*)(lds + RL_BT + t * SA64 + ch0 * 2) = (v4u){ob[0], ob[1], ob[2], ob[3]};
        *(LAS v4u*)(lds + RL_KT + t * SA64 + ch0 * 2) = (v4u){ok[0], ok[1], ok[2], ok[3]};
        *(LAS v4u*)(lds + RL_RT + t * SA64 + ch0 * 2) = (v4u){orr[0], orr[1], orr[2], orr[3]};
#pragma unroll
        for (int e = 0; e < 8; ++e) { *(LAS bf16*)(lds + RL_BHT + (ch0 + e) * SA64 + t * 2) = (bf16)f2bf(bh[e]); *(LAS bf16*)(lds + RL_KHT + (ch0 + e) * SA64 + t * 2) = (bf16)f2bf(kh[e]);
            *(LAS bf16*)(lds + RL_VT + (ch0 + e) * SA64 + t * 2) = (bf16)f2bf(xv[e]); }
        *(v4u*)(mix + (trow0 + t) * D + h * 64 + ch0) = (v4u){cvt_pk_bf16(xv[0], xv[1]), cvt_pk_bf16(xv[2], xv[3]), cvt_pk_bf16(xv[4], xv[5]), cvt_pk_bf16(xv[6], xv[7])};
        bon += __shfl_xor(bon, 1); bon += __shfl_xor(bon, 2); bon += __shfl_xor(bon, 4);
        if ((tid & 7) == 0) bonus[(trow0 + t) * 8 + h] = bon;
    }
    __syncthreads();
    }
    { int tid = tid0; asm volatile("" : "+v"(tid)); const int lane = tid & 63, wave = __builtin_amdgcn_readfirstlane(tid >> 6), q16 = lane & 15, g4 = lane >> 4; (void)lane; (void)wave; (void)q16; (void)g4;
    for (int ti = wave; ti < 16; ti += 8) {
        const int mt = ti >> 2, nt = ti & 3;
        f32x4 ab = (f32x4){0.f, 0.f, 0.f, 0.f}, ak = ab, rb = ab, rk = ab;
        if (nt <= mt) {
#pragma unroll
            for (int ks = 0; ks < 2; ++ks) { const int kb = ks * 64 + g4 * 16;
                const bf16x8 fb = ldfrag(lds + RL_BT, 16 * nt + q16, SA64, kb), fk = ldfrag(lds + RL_KT, 16 * nt + q16, SA64, kb), ga = ldfrag(lds + RL_AT, 16 * mt + q16, SA64, kb), gr = ldfrag(lds + RL_RT, 16 * mt + q16, SA64, kb);
                ab = mfma16(fb, ga, ab); ak = mfma16(fk, ga, ak); rb = mfma16(fb, gr, rb); rk = mfma16(fk, gr, rk); }
            if (nt == mt) {
#pragma unroll
                for (int r = 0; r < 4; ++r) { if (4 * g4 + r >= q16) { ab[r] = 0.f; ak[r] = 0.f; } if (4 * g4 + r > q16) { rb[r] = 0.f; rk[r] = 0.f; } } }
        }
        const int t = 16 * mt + q16, s0 = 16 * nt + 4 * g4;
        *(LAS f32x4*)(lds + RL_AAB + t * 256 + s0 * 4) = ab;
        *(LAS u32x2*)(lds + RL_AAK + t * SA64 + s0 * 2) = (u32x2){cvt_pk_bf16(ak[0], ak[1]), cvt_pk_bf16(ak[2], ak[3])};
        *(LAS u32x2*)(lds + RL_ARB + t * SA64 + s0 * 2) = (u32x2){cvt_pk_bf16(rb[0], rb[1]), cvt_pk_bf16(rb[2], rb[3])};
        *(LAS u32x2*)(lds + RL_ARK + t * SA64 + s0 * 2) = (u32x2){cvt_pk_bf16(rk[0], rk[1]), cvt_pk_bf16(rk[2], rk[3])};
    }
    __syncthreads();
    }
    { int tid = tid0; asm volatile("" : "+v"(tid)); const int lane = tid & 63, wave = __builtin_amdgcn_readfirstlane(tid >> 6), q16 = lane & 15, g4 = lane >> 4; (void)lane; (void)wave; (void)q16; (void)g4;
    for (int ti = wave; ti < 16; ti += 8) {
        const int mt = ti >> 2, nt = ti & 3;
        f32x4 acc = (f32x4){0.f, 0.f, 0.f, 0.f};
#pragma unroll
        for (int ks = 0; ks < 2; ++ks) acc = mfma16(ldfrag(lds + RL_VT, 16 * nt + q16, SA64, ks * 64 + g4 * 16), ldfrag(lds + RL_AAK, 16 * mt + q16, SA64, ks * 64 + g4 * 16), acc);
        *(LAS f32x4*)(lds + RL_X2 + (16 * mt + q16) * FS + (16 * nt + 4 * g4) * 4) = acc;
    }
    __syncthreads();
    }
    { int tid = tid0; asm volatile("" : "+v"(tid)); const int lane = tid & 63, wave = __builtin_amdgcn_readfirstlane(tid >> 6), q16 = lane & 15, g4 = lane >> 4; (void)lane; (void)wave; (void)q16; (void)g4;
    if (wave < 2) sub_solve(lds, lane, wave);
    __syncthreads();
    }
    { int tid = tid0; asm volatile("" : "+v"(tid)); const int lane = tid & 63, wave = __builtin_amdgcn_readfirstlane(tid >> 6), q16 = lane & 15, g4 = lane >> 4; (void)lane; (void)wave; (void)q16; (void)g4;
    for (int ti = wave; ti < 16; ti += 8) {
        const int mt = ti >> 2, nt = ti & 3;
        f32x4 aL = (f32x4){0.f, 0.f, 0.f, 0.f}, aR = aL, aN = aL, aY = aL;
#pragma unroll
        for (int ks = 0; ks < 2; ++ks) { const int kb = ks * 64 + g4 * 16;
            const bf16x8 wt_n = ldfrag(lds + RL_WT, 16 * nt + q16, SA64, kb);
            aL = mfma16(wt_n, ldfrag(lds + RL_BHT, 16 * mt + q16, SA64, kb), aL);
            aR = mfma16(wt_n, ldfrag(lds + RL_ARB, 16 * mt + q16, SA64, kb), aR);
            const bf16x8 ut_m = ldfrag(lds + RL_UT, 16 * mt + q16, SA64, kb), vt_m = ldfrag(lds + RL_VT, 16 * mt + q16, SA64, kb);
            aN = mfma16(ldfrag(lds + RL_BHT, 16 * nt + q16, SA64, kb), ut_m, aN); aN = mfma16(ldfrag(lds + RL_KHT, 16 * nt + q16, SA64, kb), vt_m, aN);
            aY = mfma16(ldfrag(lds + RL_ARB, 16 * nt + q16, SA64, kb), ut_m, aY); aY = mfma16(ldfrag(lds + RL_ARK, 16 * nt + q16, SA64, kb), vt_m, aY);
        }
        const int row = 16 * mt + q16, col0 = 16 * nt + 4 * g4;
        const u32x2 rt = *(const LAS u32x2*)(lds + RL_RT + row * SA64 + col0 * 2);
        aR[0] += bflo(rt.x); aR[1] += bfhi(rt.x); aR[2] += bflo(rt.y); aR[3] += bfhi(rt.y);
        *(u32x2*)(uo + RU_L + row * 128 + col0 * 2) = (u32x2){cvt_pk_bf16(aL[0], aL[1]), cvt_pk_bf16(aL[2], aL[3])};
        *(u32x2*)(uo + RU_RM + row * 128 + col0 * 2) = (u32x2){cvt_pk_bf16(aR[0], aR[1]), cvt_pk_bf16(aR[2], aR[3])};
        *(u32x2*)(uo + RU_NT + row * 128 + col0 * 2) = (u32x2){cvt_pk_bf16(aN[0], aN[1]), cvt_pk_bf16(aN[2], aN[3])};
        *(u32x2*)(uo + RU_YT + row * 128 + col0 * 2) = (u32x2){cvt_pk_bf16(aY[0], aY[1]), cvt_pk_bf16(aY[2], aY[3])};
    }
    __syncthreads();
    }
}

DEV void rwkv_seqB(int bh, const unsigned char* iar, const float* gcr, const bf16* g_r, const float* bonus, const float* ln_w, const float* ln_b, bf16* mix, LAS float* red, int tid) {
    const int lane = tid & 63, wave = tid >> 6, q16 = lane & 15, g4 = lane >> 4;
    const int h = bh & 7, b = bh >> 3, v = 16 * (wave & 3) + q16, chg = h * 64 + v;
    const bool act = wave < 4;
    const float lw = ln_w[chg], lb = ln_b[chg];
    f32x4 S[4];
#pragma unroll
    for (int i = 0; i < 4; ++i) S[i] = (f32x4){0.f, 0.f, 0.f, 0.f};
    for (int c = 0; c < NCH; ++c) {
        const int unit = bh * NCH + c;
        const unsigned char* ui = iar + (size_t)unit * RU_BYTES;
        const size_t trow0 = (size_t)b * SEQ + (size_t)c * CH;
        f32x4 y[4];
        float sy[4][4], sq[4][4];
        if (act) {
            bf16x8 sb[2];
#pragma unroll
            for (int ks = 0; ks < 2; ++ks) { const v4u t4 = (v4u){cvt_pk_bf16(S[2 * ks][0], S[2 * ks][1]), cvt_pk_bf16(S[2 * ks][2], S[2 * ks][3]), cvt_pk_bf16(S[2 * ks + 1][0], S[2 * ks + 1][1]), cvt_pk_bf16(S[2 * ks + 1][2], S[2 * ks + 1][3])};
                sb[ks] = __builtin_bit_cast(bf16x8, t4); }
#pragma unroll
            for (int mt = 0; mt < 4; ++mt) {
                const u32x2 yi = *(const u32x2*)(ui + RU_YT + v * 128 + (16 * mt + 4 * g4) * 2);
                f32x4 acc = (f32x4){bflo(yi.x), bfhi(yi.x), bflo(yi.y), bfhi(yi.y)};
#pragma unroll
                for (int ks = 0; ks < 2; ++ks) { const unsigned char* rrow = ui + RU_RM + (16 * mt + q16) * 128 + ks * 64;
                    const u32x2 a0 = *(const u32x2*)(rrow + g4 * 8), a1 = *(const u32x2*)(rrow + 32 + g4 * 8); const v4u a4 = (v4u){a0.x, a0.y, a1.x, a1.y};
                    acc = mfma16(__builtin_bit_cast(bf16x8, a4), sb[ks], acc); }
                y[mt] = acc;
            }
            f32x4 Sn[4];
#pragma unroll
            for (int kt = 0; kt < 4; ++kt) {
                const u32x2 ni = *(const u32x2*)(ui + RU_NT + v * 128 + (16 * kt + 4 * g4) * 2);
                const f32x4 gc = *(const f32x4*)(gcr + (size_t)unit * 64 + 16 * kt + 4 * g4);
                f32x4 acc = (f32x4){bflo(ni.x) + gc[0] * S[kt][0], bfhi(ni.x) + gc[1] * S[kt][1], bflo(ni.y) + gc[2] * S[kt][2], bfhi(ni.y) + gc[3] * S[kt][3]};
#pragma unroll
                for (int ks = 0; ks < 2; ++ks) { const unsigned char* lrow = ui + RU_L + (16 * kt + q16) * 128 + ks * 64;
                    const u32x2 a0 = *(const u32x2*)(lrow + g4 * 8), a1 = *(const u32x2*)(lrow + 32 + g4 * 8); const v4u a4 = (v4u){a0.x, a0.y, a1.x, a1.y};
                    acc = mfma16(__builtin_bit_cast(bf16x8, a4), sb[ks], acc); }
                Sn[kt] = acc;
            }
#pragma unroll
            for (int kt = 0; kt < 4; ++kt) S[kt] = Sn[kt];
#pragma unroll
            for (int mt = 0; mt < 4; ++mt)
#pragma unroll
                for (int r = 0; r < 4; ++r) { float s1 = y[mt][r], s2 = s1 * s1;
                    s1 += __shfl_xor(s1, 1); s2 += __shfl_xor(s2, 1); s1 += __shfl_xor(s1, 2); s2 += __shfl_xor(s2, 2); s1 += __shfl_xor(s1, 4); s2 += __shfl_xor(s2, 4); s1 += __shfl_xor(s1, 8); s2 += __shfl_xor(s2, 8);
                    sy[mt][r] = s1; sq[mt][r] = s2; }
        }
        __syncthreads();
        if (act && q16 == 0) {
#pragma unroll
            for (int mt = 0; mt < 4; ++mt)
#pragma unroll
                for (int r = 0; r < 4; ++r) { const int t = 16 * mt + 4 * g4 + r; red[t * 8 + wave * 2] = sy[mt][r]; red[t * 8 + wave * 2 + 1] = sq[mt][r]; } }
        __syncthreads();
        if (act) {
#pragma unroll
            for (int mt = 0; mt < 4; ++mt)
#pragma unroll
                for (int r = 0; r < 4; ++r) { const int t = 16 * mt + 4 * g4 + r;
                    const LAS f32x4* rp = (const LAS f32x4*)(red + t * 8); const f32x4 r0 = rp[0], r1 = rp[1];
                    const float mean = ((r0[0] + r0[2]) + (r1[0] + r1[2])) * (1.f / 64.f), ex2 = ((r0[1] + r0[3]) + (r1[1] + r1[3])) * (1.f / 64.f);
                    const float var = fmaxf(ex2 - mean * mean, 0.f);
                    const size_t tr = trow0 + t;
                    const float vv = bf2f(mix[tr * D + chg]), gg = bf2f(g_r[tr * DR + chg]), bo = bonus[tr * 8 + h];
                    mix[tr * D + chg] = (bf16)f2bf(((y[mt][r] - mean) * rsqrtf(var + GN_EPS) * lw + lb + bo * vv) * gg); }
        }
    }
}
DEV void ph_norm2_router(const float* h, const float* g2, const float* wrt, const float* bg, const float* be, bf16* hn,
                         unsigned* cnt, int* tok_e, int* tok_pos, float* tok_gate, int gw, int NGW, int lane) {
    for (int t = gw; t < T; t += NGW) {
        const f32x4* xr = (const f32x4*)(h + (size_t)t * D) + lane; const f32x4* gr = (const f32x4*)g2 + lane;
        f32x4 v[4]; float s = 0.f;
#pragma unroll
        for (int j = 0; j < 4; ++j) { v[j] = xr[64 * j]; s += (v[j].x * v[j].x + v[j].y * v[j].y) + (v[j].z * v[j].z + v[j].w * v[j].w); }
        const float rstd = rsqrtf(wave_sum(s) * (1.f / D) + RMS_EPS);
        unsigned long long* o8 = (unsigned long long*)(hn + (size_t)t * D) + lane;
#pragma unroll
        for (int j = 0; j < 4; ++j) { v[j] = v[j] * rstd * gr[64 * j]; o8[64 * j] = (unsigned long long)pk2(v[j].x, v[j].y) | ((unsigned long long)pk2(v[j].z, v[j].w) << 32); }
        float L[36];
#pragma unroll
        for (int e = 0; e < 36; ++e) { const float* wp = wrt + e * D; asm volatile("" : "+s"(wp)); const f32x4* wr = (const f32x4*)wp + lane; float a = 0.f;
#pragma unroll
            for (int j = 0; j < 4; ++j) { const f32x4 w = wr[64 * j]; a += (v[j].x * w.x + v[j].y * w.y) + (v[j].z * w.z + v[j].w * w.w); }
            L[e] = wave_sum(a); asm volatile("" ::: "memory"); }
        float gl[4]; float gm = -1e30f; int gi = 0;
#pragma unroll
        for (int g = 0; g < 4; ++g) { gl[g] = L[g] + bg[g]; if (gl[g] > gm) { gm = gl[g]; gi = g; } }
        float gs = 0.f;
#pragma unroll
        for (int g = 0; g < 4; ++g) gs += __expf(gl[g] - gm);
        const float g_w = 1.f / gs;
        float el[8];
#pragma unroll
        for (int j = 0; j < 8; ++j) el[j] = 0.f;
#pragma unroll
        for (int g = 0; g < 4; ++g) if (g == gi) {
#pragma unroll
            for (int j = 0; j < 8; ++j) el[j] = L[4 + 8 * g + j] + be[8 * g + j]; }
        float m1 = -1e30f; int i1 = 0;
#pragma unroll
        for (int j = 0; j < 8; ++j) if (el[j] > m1) { m1 = el[j]; i1 = j; }
        float m2 = -1e30f; int i2 = 0;
#pragma unroll
        for (int j = 0; j < 8; ++j) if (j != i1 && el[j] > m2) { m2 = el[j]; i2 = j; }
        const float p2 = __expf(m2 - m1), w1 = 1.f / (1.f + p2), w2 = p2 / (1.f + p2);
        if (lane == 0) {
            const int e1 = gi * 8 + i1, e2 = gi * 8 + i2;
            const unsigned q1 = atomicAdd(cnt + e1, 1u), q2 = atomicAdd(cnt + e2, 1u);
            tok_e[2 * t] = e1; tok_e[2 * t + 1] = e2; tok_pos[2 * t] = (int)q1; tok_pos[2 * t + 1] = (int)q2; tok_gate[2 * t] = g_w * w1; tok_gate[2 * t + 1] = g_w * w2;
        }
    }
}
DEV void ph_scatter(const bf16* hn, const unsigned* cnt, const int* tok_e, const int* tok_pos, int* misc, bf16* xg, int* tok_slot, LAS int* offs, int gw, int NGW, int lane, int tid) {
    __syncthreads();
    if (tid == 0) { int off = 0, nt = 0; const bool wr = blockIdx.x == 0;
        for (int e = 0; e < NE; ++e) { const int c = (int)__hip_atomic_load(cnt + e, __ATOMIC_RELAXED, __HIP_MEMORY_SCOPE_AGENT), tiles = (c + 255) >> 8; offs[e] = off;
            if (wr) for (int i = 0; i < tiles; ++i) misc[64 + nt + i] = e;
            nt += tiles; off += tiles * 256; }
        if (wr) misc[0] = nt; }
    __syncthreads();
    for (int t = gw; t < T; t += NGW) {
        const v4u* src = (const v4u*)(hn + (size_t)t * D) + lane;
        const v4u a = src[0], b = src[64];
#pragma unroll
        for (int k = 0; k < 2; ++k) { const int e = tok_e[2 * t + k], slot = offs[e] + tok_pos[2 * t + k];
            v4u* dst = (v4u*)(xg + (size_t)slot * D) + lane; dst[0] = a; dst[64] = b;
            if (lane == 0) tok_slot[2 * t + k] = slot; }
    }
}
DEV void ph_final(float* h, const bf16* yo, const int* tok_slot, const float* tok_gate, const float* gf, int gw, int NGW, int lane) {
    for (int t = gw; t < T; t += NGW) {
        f32x4* xr = (f32x4*)(h + (size_t)t * D) + lane; const f32x4* gr = (const f32x4*)gf + lane;
        const int s1 = tok_slot[2 * t], s2 = tok_slot[2 * t + 1]; const float g1 = tok_gate[2 * t], g2 = tok_gate[2 * t + 1];
        const unsigned long long* y1 = (const unsigned long long*)(yo + (size_t)s1 * D) + lane; const unsigned long long* y2 = (const unsigned long long*)(yo + (size_t)s2 * D) + lane;
        f32x4 v[4]; float s = 0.f;
#pragma unroll
        for (int j = 0; j < 4; ++j) { v[j] = xr[64 * j]; const unsigned long long a = y1[64 * j], b = y2[64 * j];
            v[j].x += g1 * bf2f((bf16)(a & 0xffff)) + g2 * bf2f((bf16)(b & 0xffff));
            v[j].y += g1 * bf2f((bf16)((a >> 16) & 0xffff)) + g2 * bf2f((bf16)((b >> 16) & 0xffff));
            v[j].z += g1 * bf2f((bf16)((a >> 32) & 0xffff)) + g2 * bf2f((bf16)((b >> 32) & 0xffff));
            v[j].w += g1 * bf2f((bf16)(a >> 48)) + g2 * bf2f((bf16)(b >> 48));
            s += (v[j].x * v[j].x + v[j].y * v[j].y) + (v[j].z * v[j].z + v[j].w * v[j].w); }
        const float rstd = rsqrtf(wave_sum(s) * (1.f / D) + RMS_EPS);
#pragma unroll
        for (int j = 0; j < 4; ++j) xr[64 * j] = v[j] * rstd * gr[64 * j];
    }
}

#ifndef MK_N_LAUNCHES
#define MK_N_LAUNCHES 1
#endif
constexpr int N_PHASES = 11;
struct Args { const float* in[27]; float* out; unsigned char* ws; int ph_lo, ph_hi; };
__global__ void __launch_bounds__(NTHR, 2) mega_kernel(Args args) {
    extern __shared__ __attribute__((aligned(16))) unsigned char lds_raw[];
    LAS unsigned char* lds = (LAS unsigned char*)lds_raw;
    volatile LAS unsigned* MISC = (volatile LAS unsigned*)(lds + MISC_OFF);
    const int tid = threadIdx.x, lane = tid & 63, wave = __builtin_amdgcn_readfirstlane(tid >> 6);
    const int G = gridDim.x, blk = blockIdx.x, gw = blk * NWAVES + wave, NGW = G * NWAVES;
    unsigned char* ws = args.ws; float* out = args.out; const float* const* in = args.in;
    bf16 *win_t = (bf16*)(ws + WS_WIN), *wout_t = (bf16*)(ws + WS_WOUT), *wgu_t = (bf16*)(ws + WS_WGU), *wd_t = (bf16*)(ws + WS_WD);
    bf16 *xn = (bf16*)(ws + WS_XN), *p = (bf16*)(ws + WS_P), *xg = (bf16*)(ws + WS_XG), *H = (bf16*)(ws + WS_H), *yo = (bf16*)(ws + WS_YO);
    float* wrt = (float*)(ws + WS_WRT); unsigned* ctl = (unsigned*)(ws + WS_CTL); unsigned* cnt = ctl + CW_CNT; int* misc = (int*)(ws + WS_MISC);
    int* tok_e = (int*)(ws + WS_TOK); int* tok_pos = tok_e + 2 * T; float* tok_gate = (float*)(tok_pos + 2 * T); int* tok_slot = (int*)(tok_gate + 2 * T);
    bf16* lora = (bf16*)(ws + WS_LORA); float* gcr = (float*)(ws + WS_GCR); float* bonus = (float*)(ws + WS_BONUS); float* dch = (float*)(ws + WS_DCH); bf16* g_r = (bf16*)(ws + WS_GR);
    for (int u = tid; u < (LDS_BYTES - LDSCTL_OFF) / 4; u += NTHR) ((LAS unsigned*)(lds + LDSCTL_OFF))[u] = 0u;
    __syncthreads();
    XcdBarrier bar; bar.bar = ctl + CW_BAR; bar.x = 0; bar.st = nullptr;
    const int lo = args.ph_lo, hi = args.ph_hi;
    if (hi - lo > 1) bar = xcd_barrier_post(ctl + CW_BAR, MISC + 8);
#define IN(k) (lo <= (k) && (k) < hi)
#define SEAM(k) do { if (IN(k) && IN((k) + 1)) xcd_barrier(bar); } while (0)
    LAS float* wscr = (LAS float*)(lds + wave * 16384);

    if (IN(0)) { ph_prep1(in[2], in[17], in[19], in[21], in[5], in[7], in[8], win_t, wout_t, wrt, lora, wscr, gw, NGW, lane); ph_rmsnorm(in[0], in[1], xn, gw, NGW, lane); }
    SEAM(0);
    if (IN(1)) { pg8::Gemm g{D}; pg8::StaticOrder S; S.init(xn, win_t, T, DIN, D, G, blk); pg8::EpiBf16 E{p, DIN};
        pg8::gemm_phase<pg8::EpiBf16, pg8::StaticOrder, true, true>(lds, g, S, E); }
    SEAM(1);
    if (IN(2)) {
        for (int u = blk; u < BATCH * 8 * NCH; u += G) rwkv_unitA(u, p, in[3], in[4], in[6], in[9], in[10], in[11], lora, lora + 512 * 64, lora + 2 * 512 * 64, ws + WS_IAR, gcr, g_r, bonus, xn, lds, tid);
        for (int u = blk; u < BATCH * 4 * NCH; u += G) hgrn_unitA(u, p, in[14], in[15], (unsigned char*)out, dch, xn, lds, tid); }
    SEAM(2);
    if (IN(3)) {
        if (blk < BATCH * 8) rwkv_seqB(blk, ws + WS_IAR, gcr, g_r, bonus, in[12], in[13], xn, (LAS float*)lds, tid);
        else if (blk < BATCH * 8 + BATCH * 4) hgrn_seqB(blk - BATCH * 8, (const unsigned char*)out, dch, in[16], xn, (LAS float*)lds, tid); }
    SEAM(3);
    if (IN(4)) ph_prep2(in[23], in[24], in[25], wgu_t, wd_t, wscr, gw, NGW, lane);
    SEAM(4);
    if (IN(5)) { pg8::Gemm g{D}; pg8::StaticOrder S; S.init(xn, wout_t, T, D, D, G, blk); pg8::EpiResF32 E{in[0], out, D};
        pg8::gemm_phase<pg8::EpiResF32, pg8::StaticOrder, true, true>(lds, g, S, E); }
    SEAM(5);
    if (IN(6)) ph_norm2_router(out, in[18], wrt, in[20], in[22], xn, cnt, tok_e, tok_pos, tok_gate, gw, NGW, lane);
    SEAM(6);
    if (IN(7)) ph_scatter(xn, cnt, tok_e, tok_pos, misc, xg, tok_slot, (LAS int*)lds, gw, NGW, lane, tid);
    SEAM(7);
    if (IN(8)) { const int ntiles = __builtin_amdgcn_readfirstlane(misc[0]); pg8::Gemm g{D}; pg8::MoeOrder S; S.init(xg, wgu_t, misc + 64, ntiles, 1024, D, G, blk); pg8::EpiSwiGLU E{H, DE};
        pg8::gemm_phase<pg8::EpiSwiGLU, pg8::MoeOrder, true, true>(lds, g, S, E); }
    SEAM(8);
    if (IN(9)) { const int ntiles = __builtin_amdgcn_readfirstlane(misc[0]); pg8::Gemm g{DE}; pg8::MoeOrder S; S.init(H, wd_t, misc + 64, ntiles, D, DE, G, blk); pg8::EpiBf16 E{yo, D};
        pg8::gemm_phase<pg8::EpiBf16, pg8::MoeOrder, true, true>(lds, g, S, E); }
    SEAM(9);
    if (IN(10)) ph_final(out, yo, tok_slot, tok_gate, in[26], gw, NGW, lane);
#undef IN
#undef SEAM
}

extern "C" void kernel_launch(void* const* d_in, const int* in_sizes, int n_in, void* d_out, int out_size, void* d_ws, size_t ws_size, hipStream_t stream) {
    static int grid = 0;
    if (grid == 0) {
        if (n_in != 27 || in_sizes[0] != T * D || out_size != T * D || ws_size < WS_END) { fprintf(stderr, "kernel_launch: unexpected shapes (n_in %d, in0 %d, out %d, ws %zu)\n", n_in, n_in > 0 ? in_sizes[0] : -1, out_size, ws_size); grid = -1; return; }
        int dev = 0, cus = 0;
        if (hipGetDevice(&dev) != hipSuccess || hipDeviceGetAttribute(&cus, hipDeviceAttributeMultiprocessorCount, dev) != hipSuccess) { grid = -1; return; }
        if (hipFuncSetAttribute((const void*)mega_kernel, hipFuncAttributeMaxDynamicSharedMemorySize, LDS_BYTES) != hipSuccess) { fprintf(stderr, "kernel_launch: hipFuncSetAttribute failed\n"); grid = -1; return; }
        grid = cus;
    }
    if (grid < 0) return;
    if (hipMemsetAsync((char*)d_ws + WS_CTL, 0, CTL_ZERO_BYTES, stream) != hipSuccess) return;
    Args a{};
    for (int i = 0; i < 27; ++i) a.in[i] = (const float*)d_in[i];
    a.out = (float*)d_out; a.ws = (unsigned char*)d_ws;
    if (MK_N_LAUNCHES == 1) { a.ph_lo = 0; a.ph_hi = N_PHASES; hipLaunchKernelGGL(mega_kernel, dim3(grid), dim3(NTHR), LDS_BYTES, stream, a); }
    else for (int k = 0; k < N_PHASES; ++k) { a.ph_lo = k; a.ph_hi = k + 1; hipLaunchKernelGGL(mega_kernel, dim3(grid), dim3(NTHR), LDS_BYTES, stream, a); }
}
```

```cpp
#include <hip/hip_runtime.h>
#include <cstdint>
#include <cstdio>

typedef unsigned short bf16;
#define DEV __device__ __forceinline__
DEV float bf2f(bf16 v) { return __uint_as_float(((unsigned)v) << 16); }
DEV unsigned f2bf(float f) { unsigned u = __float_as_uint(f); return (u + 0x7fffu + ((u >> 16) & 1u)) >> 16; }
DEV unsigned pk2(float lo, float hi) { return f2bf(lo) | (f2bf(hi) << 16); }
typedef float f32x2_t __attribute__((ext_vector_type(2)));
typedef __bf16 bf16x2_t __attribute__((ext_vector_type(2)));
DEV unsigned cvt_pk_bf16(float lo, float hi) { const f32x2_t v = {lo, hi}; return __builtin_bit_cast(unsigned, __builtin_convertvector(v, bf16x2_t)); }
DEV float wave_sum(float v) {
#pragma unroll
    for (int o = 1; o < 64; o <<= 1) v += __shfl_xor(v, o);
    return v;
}
DEV float rdlane(float x, int k) { return __uint_as_float(__builtin_amdgcn_readlane(__float_as_uint(x), k)); }
DEV float sigmoidf_(float x) { return 1.0f / (1.0f + __expf(-x)); }
DEV float bflo(unsigned w) { return __uint_as_float(w << 16); }
DEV float bfhi(unsigned w) { return __uint_as_float(w & 0xffff0000u); }

constexpr int BATCH = 8, SEQ = 2048, T = BATCH * SEQ, D = 1024;
constexpr int DR = 512, DH = 512, DRIN = 1792, DHIN = 2048, DIN = 3840;
constexpr int NE = 32, DE = 512;
constexpr float RMS_EPS = 1e-6f, GN_EPS = 64e-5f, L2_EPS = 1e-12f;
constexpr int MAXTILES = 160, MP = MAXTILES * 256;

constexpr size_t MiB = 1u << 20;
constexpr size_t WS_CTL = 0;
constexpr size_t WS_MISC = 64 * 1024;
constexpr size_t WS_WRT = 256 * 1024;
constexpr size_t WS_TOK = 512 * 1024;
constexpr size_t WS_WIN = 1 * MiB;
constexpr size_t WS_WOUT = 9 * MiB;
constexpr size_t WS_WGU = 11 * MiB;
constexpr size_t WS_WD = 75 * MiB;
constexpr size_t WS_XN = 107 * MiB;
constexpr size_t WS_P = 139 * MiB;
constexpr size_t WS_XG = WS_P, WS_H = WS_P + 80 * MiB, WS_YO = WS_P;
constexpr size_t WS_END = 260 * MiB;
constexpr size_t WS_IAR = 11 * MiB;
constexpr size_t WS_GCR = 259 * MiB;
constexpr size_t WS_DCH = 259 * MiB + 512 * 1024;
constexpr size_t WS_LORA = 8 * MiB + 512 * 1024;
namespace pg8 {
#define PG8_LAS __attribute__((address_space(3)))
typedef unsigned short bf16_t;
typedef short bf16x8 __attribute__((ext_vector_type(8)));
typedef float f32x4 __attribute__((ext_vector_type(4)));
typedef unsigned u32x4 __attribute__((ext_vector_type(4)));
constexpr int BM = 256, BK = 64, HALF = 128, HTB = HALF * BK * 2  , STAGE_BYTES = 8 * HTB, NXCD = 8, WGM = 8;

__host__ __device__ __forceinline__ int lds_byte(int r, int c) { const int st = (r >> 4) * 2 + (c >> 5), rr = r & 15, cc = c & 31, ob = rr * 64 + cc * 2; return st * 1024 + (ob ^ (((ob >> 9) & 1) << 5)); }
__host__ __device__ __forceinline__ void stage_rc(int b, int& R, int& C) { const int st = b / 1024, sb = b % 1024, swz = sb ^ (((sb >> 9) & 1) << 5); R = (st >> 1) * 16 + swz / 64; C = (st & 1) * 32 + (swz % 64) / 2; }
__host__ __device__ __forceinline__ int perm32(int rho) { const int n = rho >> 4, i = rho & 15; return 8 * (i >> 2) + 4 * n + (i & 3); }

struct Unit { int pm, pn; const char* a; const char* b; };
struct Gemm { int K; };

__device__ __forceinline__ bool order_unit(long L, int nM, int nN, int& pm, int& pn) {
    const int nwg = nM * nN; if (L >= nwg) return false;
    int wgid = (int)L; { const int q = nwg / NXCD, r = nwg % NXCD, xcd = wgid % NXCD, off = wgid / NXCD; wgid = (xcd < r ? xcd * (q + 1) : r * (q + 1) + (xcd - r) * q) + off; }
    const int nig = WGM * nN, gid = wgid / nig, fm = gid * WGM, gsz = (nM - fm) < WGM ? (nM - fm) : WGM;
    pm = fm + ((wgid % nig) % gsz); pn = (wgid % nig) / gsz; return true;
}
struct StaticOrder {
    const char* A; const char* Bt; int nM, nN, G, c; size_t tstep;
    __device__ void init(const void* A_, const void* Bt_, int M, int N, int K, int G_, int c_) { A = (const char*)A_; Bt = (const char*)Bt_; nM = M / BM; nN = N / BM; G = G_; c = c_; tstep = (size_t)BM * K * 2; }
    __device__ bool next(int i, Unit& u) const {
        if (!order_unit((long)i * G + c, nM, nN, u.pm, u.pn)) return false;
        u.a = A + (size_t)u.pm * tstep; u.b = Bt + (size_t)u.pn * tstep; return true;
    }
    __device__ __forceinline__ void a_ready(const Unit&) const {}
    __device__ __forceinline__ void done(const Unit&) const {}
};
struct MoeOrder {
    const char* A; const char* Bt; const int* tile_expert; int nM, nN, G, c; size_t tstep, estep;
    __device__ void init(const void* A_, const void* Bt_, const int* te, int ntiles, int N, int K, int G_, int c_) { A = (const char*)A_; Bt = (const char*)Bt_; tile_expert = te; nM = ntiles; nN = N / BM; G = G_; c = c_; tstep = (size_t)BM * K * 2; estep = (size_t)N * K * 2; }
    __device__ bool next(int i, Unit& u) const {
        if (!order_unit((long)i * G + c, nM, nN, u.pm, u.pn)) return false;
        const int e = __builtin_amdgcn_readfirstlane(tile_expert[u.pm]);
        u.a = A + (size_t)u.pm * tstep; u.b = Bt + (size_t)e * estep + (size_t)u.pn * tstep; return true;
    }
    __device__ __forceinline__ void a_ready(const Unit&) const {}
    __device__ __forceinline__ void done(const Unit&) const {}
};

using ::cvt_pk_bf16;

struct EpiBf16 {
    static constexpr bool PERM = true, AFTER_DRAIN = false;
    bf16_t* O; int ldc;
    __device__ __forceinline__ void operator()(const f32x4 (&acc)[2][2][4][2], const Unit& u, int wr, int wc, int fr, int fq) const {
        const int row0 = u.pm * BM + wr * 64 + fr, col0 = u.pn * BM + wc * 32 + 8 * fq;
#pragma unroll
        for (int ai = 0; ai < 2; ++ai)
#pragma unroll
            for (int m = 0; m < 4; ++m) { bf16_t* rowp = O + (size_t)(row0 + ai * HALF + m * 16) * ldc + col0;
#pragma unroll
                for (int bj = 0; bj < 2; ++bj) { const f32x4 v0 = acc[ai][bj][m][0], v1 = acc[ai][bj][m][1];
                    u32x4 w; w.x = cvt_pk_bf16(v0[0], v0[1]); w.y = cvt_pk_bf16(v0[2], v0[3]); w.z = cvt_pk_bf16(v1[0], v1[1]); w.w = cvt_pk_bf16(v1[2], v1[3]);
                    *(u32x4*)(rowp + bj * HALF) = w; } }
    }
};
struct EpiResF32 {
    static constexpr bool PERM = false, AFTER_DRAIN = false;
    const float* base; float* C; int ldc;
    __device__ __forceinline__ void operator()(const f32x4 (&acc)[2][2][4][2], const Unit& u, int wr, int wc, int fr, int fq) const {
        const int row0 = u.pm * BM + wr * 64 + fr, col0 = u.pn * BM + wc * 32 + 4 * fq;
#pragma unroll
        for (int ai = 0; ai < 2; ++ai)
#pragma unroll
            for (int m = 0; m < 4; ++m) { const size_t off = (size_t)(row0 + ai * HALF + m * 16) * ldc + col0;
#pragma unroll
                for (int bj = 0; bj < 2; ++bj)
#pragma unroll
                    for (int n = 0; n < 2; ++n) *(f32x4*)(C + off + bj * HALF + n * 16) = *(const f32x4*)(base + off + bj * HALF + n * 16) + acc[ai][bj][m][n]; }
    }
};
struct EpiSwiGLU {
    static constexpr bool PERM = true, AFTER_DRAIN = false;
    bf16_t* H; int ldh;
    __device__ __forceinline__ void operator()(const f32x4 (&acc)[2][2][4][2], const Unit& u, int wr, int wc, int fr, int fq) const {
        const int row0 = u.pm * BM + wr * 64 + fr, col0 = u.pn * HALF + wc * 32 + 8 * fq;
#pragma unroll
        for (int ai = 0; ai < 2; ++ai)
#pragma unroll
            for (int m = 0; m < 4; ++m) { bf16_t* rowp = H + (size_t)(row0 + ai * HALF + m * 16) * ldh + col0;
                float o[8];
#pragma unroll
                for (int n = 0; n < 2; ++n)
#pragma unroll
                    for (int j = 0; j < 4; ++j) { const float g = acc[ai][0][m][n][j], up = acc[ai][1][m][n][j]; o[n * 4 + j] = g * up * __builtin_amdgcn_rcpf(1.0f + __expf(-g)); }
                u32x4 w; w.x = cvt_pk_bf16(o[0], o[1]); w.y = cvt_pk_bf16(o[2], o[3]); w.z = cvt_pk_bf16(o[4], o[5]); w.w = cvt_pk_bf16(o[6], o[7]);
                *(u32x4*)rowp = w; }
    }
};
template <class Epi, class Sched, bool ALIGN_EPI = false, bool SP2 = false>
__device__ __forceinline__ void gemm_phase(PG8_LAS unsigned char* lds, const Gemm g, const Sched& S, const Epi& E) {
    const int tid = threadIdx.x, wid = __builtin_amdgcn_readfirstlane(tid >> 6), lane = tid & 63, wr = wid >> 2, wc = wid & 3, fr = lane & 15, fq = lane >> 4;
    const int K = g.K, nt = K / BK;
    unsigned voffA[2], voffB[2];
#pragma unroll
    for (int i = 0; i < 2; ++i) { int R, C; stage_rc(tid * 16 + i * 8192, R, C); const int Rb = Epi::PERM ? ((R & ~31) + perm32(R & 31)) : R;
        voffA[i] = (unsigned)(R * K + C) * 2u; voffB[i] = (unsigned)(Rb * K + C) * 2u; }
    const size_t kstep = (size_t)(BK * 2);
    const size_t hstep = (size_t)HALF * K * 2;
    const unsigned ldsw = (unsigned)wid * 1024u;
    const int aoff = lds_byte(wr * 64 + fr, fq * 8), boff = lds_byte(wc * 32 + fr, fq * 8);
#define PG8_SA(b, h) (((b) * 2 + (h)) * HTB)
#define PG8_SB(b, h) ((4 + (b) * 2 + (h)) * HTB)
#define PG8_STAGE(bufoff, gbase, voff) do { _Pragma("unroll") for (int _i = 0; _i < 2; ++_i) \
        __builtin_amdgcn_global_load_lds((const unsigned*)((const char*)(gbase) + (voff)[_i]), (PG8_LAS unsigned*)(lds + (bufoff) + ldsw + _i * 8192), 16, 0, 0); } while (0)
#define PG8_LDA(dst, b, h) do { _Pragma("unroll") for (int m = 0; m < 4; ++m) _Pragma("unroll") for (int k = 0; k < 2; ++k) dst[m][k] = *(const PG8_LAS bf16x8*)(lds + PG8_SA(b, h) + aoff + m * 2048 + k * 1024); } while (0)
#define PG8_LDB(dst, b, h) do { _Pragma("unroll") for (int n = 0; n < 2; ++n) _Pragma("unroll") for (int k = 0; k < 2; ++k) dst[n][k] = *(const PG8_LAS bf16x8*)(lds + PG8_SB(b, h) + boff + n * 2048 + k * 1024); } while (0)
#define PG8_MMA(ai, bj, At, Bt) do { __builtin_amdgcn_s_setprio(1); _Pragma("unroll") for (int m = 0; m < 4; ++m) _Pragma("unroll") for (int n = 0; n < 2; ++n) _Pragma("unroll") for (int k = 0; k < 2; ++k) \
        acc[ai][bj][m][n] = __builtin_amdgcn_mfma_f32_16x16x32_bf16(Bt[n][k], At[m][k], acc[ai][bj][m][n], 0, 0, 0); __builtin_amdgcn_s_setprio(0); } while (0)
#define PG8_WAIT_V(n) asm volatile("s_waitcnt vmcnt(" #n ")" ::: "memory")
#define PG8_WAIT_L(n) asm volatile("s_waitcnt lgkmcnt(" #n ")" ::: "memory")
#define PG8_BAR __builtin_amdgcn_s_barrier()
#define PG8_SCHED __builtin_amdgcn_sched_barrier(0)
    Unit cur, nxt; int ui = 0;
    if (!S.next(0, cur)) return;
    f32x4 acc[2][2][4][2];
#pragma unroll
    for (int a = 0; a < 2; ++a)
#pragma unroll
        for (int b = 0; b < 2; ++b)
#pragma unroll
            for (int m = 0; m < 4; ++m)
#pragma unroll
                for (int n = 0; n < 2; ++n) acc[a][b][m][n] = (f32x4){0.f, 0.f, 0.f, 0.f};
    bf16x8 At[4][2], B0[2][2], B1[2][2];
    const char* cA = cur.a; const char* cB = cur.b;
    S.a_ready(cur);
    if constexpr (SP2) {
        PG8_STAGE(PG8_SB(0, 0), cB, voffB); PG8_STAGE(PG8_SB(0, 1), cB + hstep, voffB); PG8_STAGE(PG8_SA(0, 0), cA, voffA); PG8_STAGE(PG8_SA(0, 1), cA + hstep, voffA);
        if (wr == 1) PG8_BAR;
        PG8_WAIT_V(2); PG8_BAR;
        PG8_STAGE(PG8_SB(1, 0), cB + kstep, voffB); PG8_STAGE(PG8_SA(1, 0), cA + kstep, voffA); PG8_STAGE(PG8_SB(1, 1), cB + hstep + kstep, voffB);
        PG8_WAIT_V(6); PG8_BAR;
    } else {
        PG8_STAGE(PG8_SB(0, 0), cB, voffB); PG8_STAGE(PG8_SA(0, 0), cA, voffA); PG8_STAGE(PG8_SB(0, 1), cB + hstep, voffB); PG8_STAGE(PG8_SA(0, 1), cA + hstep, voffA);
        if (wr == 1) PG8_BAR;
        PG8_WAIT_V(4); PG8_BAR;
        PG8_STAGE(PG8_SB(1, 0), cB + kstep, voffB); PG8_STAGE(PG8_SA(1, 0), cA + kstep, voffA); PG8_STAGE(PG8_SB(1, 1), cB + hstep + kstep, voffB);
        PG8_WAIT_V(6); PG8_BAR;
    }
    for (;;) {
        const bool has_next = S.next(ui + 1, nxt);
        const char* nA = has_next ? nxt.a : cA; const char* nB = has_next ? nxt.b : cB;
        for (int t = 0; t < nt; t += 2) {
            const bool last = (t == nt - 2);
            const char* a1 = cA + (size_t)(t + 1) * kstep;
            const char* a2 = last ? nA : cA + (size_t)(t + 2) * kstep; const char* b2 = last ? nB : cB + (size_t)(t + 2) * kstep;
            const char* a3 = a2 + kstep; const char* b3 = b2 + kstep;
            if (last && has_next) S.a_ready(nxt);
            if constexpr (SP2) {
            PG8_LDB(B0, 0, 0); PG8_LDB(B1, 0, 1); PG8_SCHED; PG8_LDA(At, 0, 0); PG8_STAGE(PG8_SA(1, 1), a1 + hstep, voffA);
            PG8_WAIT_V(8); PG8_WAIT_L(0); PG8_BAR; PG8_MMA(0, 0, At, B0); PG8_MMA(0, 1, At, B1); PG8_BAR; PG8_SCHED;
            PG8_LDA(At, 0, 1); PG8_STAGE(PG8_SB(0, 0), b2, voffB); PG8_STAGE(PG8_SB(0, 1), b2 + hstep, voffB); PG8_STAGE(PG8_SA(0, 0), a2, voffA);
            PG8_WAIT_V(8); PG8_WAIT_L(0); PG8_BAR; PG8_MMA(1, 0, At, B0); PG8_MMA(1, 1, At, B1); PG8_BAR; PG8_SCHED;
            PG8_LDB(B0, 1, 0); PG8_LDB(B1, 1, 1); PG8_SCHED; PG8_LDA(At, 1, 0); PG8_STAGE(PG8_SA(0, 1), a2 + hstep, voffA);
            PG8_WAIT_V(8); PG8_WAIT_L(0); PG8_BAR; PG8_MMA(0, 0, At, B0); PG8_MMA(0, 1, At, B1); PG8_BAR; PG8_SCHED;
            PG8_LDA(At, 1, 1); PG8_STAGE(PG8_SB(1, 0), b3, voffB); PG8_STAGE(PG8_SB(1, 1), b3 + hstep, voffB); PG8_STAGE(PG8_SA(1, 0), a3, voffA);
            PG8_WAIT_V(8); PG8_WAIT_L(0); PG8_BAR; PG8_MMA(1, 0, At, B0); PG8_MMA(1, 1, At, B1); PG8_BAR; PG8_SCHED;
            } else {
            PG8_LDB(B0, 0, 0); PG8_SCHED; PG8_LDA(At, 0, 0); PG8_STAGE(PG8_SA(1, 1), a1 + hstep, voffA);
            PG8_WAIT_L(8); PG8_BAR; PG8_WAIT_L(0); PG8_MMA(0, 0, At, B0); PG8_BAR; PG8_SCHED;
            PG8_LDB(B1, 0, 1); PG8_STAGE(PG8_SB(0, 0), b2, voffB);
            PG8_BAR; PG8_WAIT_L(0); PG8_MMA(0, 1, At, B1); PG8_BAR;
            PG8_LDA(At, 0, 1); PG8_STAGE(PG8_SA(0, 0), a2, voffA);
            PG8_BAR; PG8_WAIT_L(0); PG8_MMA(1, 0, At, B0); PG8_BAR; PG8_SCHED;
            PG8_STAGE(PG8_SB(0, 1), b2 + hstep, voffB);
            PG8_WAIT_V(6); PG8_BAR; PG8_MMA(1, 1, At, B1); PG8_BAR;
            PG8_LDB(B0, 1, 0); PG8_SCHED; PG8_LDA(At, 1, 0); PG8_STAGE(PG8_SA(0, 1), a2 + hstep, voffA);
            PG8_WAIT_L(8); PG8_BAR; PG8_WAIT_L(0); PG8_MMA(0, 0, At, B0); PG8_BAR; PG8_SCHED;
            PG8_LDB(B1, 1, 1); PG8_STAGE(PG8_SB(1, 0), b3, voffB);
            PG8_BAR; PG8_WAIT_L(0); PG8_MMA(0, 1, At, B1); PG8_BAR;
            PG8_LDA(At, 1, 1); PG8_STAGE(PG8_SA(1, 0), a3, voffA);
            PG8_BAR; PG8_WAIT_L(0); PG8_MMA(1, 0, At, B0); PG8_BAR; PG8_SCHED;
            PG8_STAGE(PG8_SB(1, 1), b3 + hstep, voffB);
            PG8_WAIT_V(6); PG8_BAR; PG8_MMA(1, 1, At, B1); PG8_BAR;
            }
        }
        if constexpr (ALIGN_EPI) { if (wr == 0) PG8_BAR; }
        if constexpr (!Epi::AFTER_DRAIN) { E(acc, cur, wr, wc, fr, fq); S.done(cur); }
        if (!has_next) break;
#pragma unroll
        for (int a = 0; a < 2; ++a)
#pragma unroll
            for (int b = 0; b < 2; ++b)
#pragma unroll
                for (int m = 0; m < 4; ++m)
#pragma unroll
                    for (int n = 0; n < 2; ++n) acc[a][b][m][n] = (f32x4){0.f, 0.f, 0.f, 0.f};
        cur = nxt; cA = nA; cB = nB; ++ui;
        if constexpr (ALIGN_EPI) { if (wr == 1) PG8_BAR; }
    }
    PG8_WAIT_V(0);
    if constexpr (!ALIGN_EPI) { if (wr == 0) PG8_BAR; }
    PG8_BAR;
    if constexpr (Epi::AFTER_DRAIN) { E.fused(acc, cur, wr, wc, fr, fq, lds, wid, lane); S.done(cur); }
#undef PG8_SA
#undef PG8_SB
#undef PG8_STAGE
#undef PG8_LDA
#undef PG8_LDB
#undef PG8_MMA
#undef PG8_WAIT_V
#undef PG8_WAIT_L
#undef PG8_BAR
#undef PG8_SCHED
}
}
#define LAS __attribute__((address_space(3)))
#define GAS __attribute__((address_space(1)))
typedef unsigned v4u __attribute__((ext_vector_type(4)));
typedef float f32x4 __attribute__((ext_vector_type(4)));
constexpr int NWAVES = 8, NTHR = 512;
constexpr int LDS_BYTES = 163840;
constexpr int LDSCTL_OFF = LDS_BYTES - 1024, MISC_OFF = LDSCTL_OFF + 320;
constexpr int CW_CNT = 0;
constexpr int CW_BAR = 1024;
constexpr size_t CTL_ZERO_BYTES = 64 * 1024;

#define XB_TMO      128
#define XB_XCNT(j)  (256  + 64 * (j))
#define XB_XSUB(j)  (1280 + 64 * (j))
#define XB_XGEN(j)  (2304 + 64 * (j))
#define XB_TOP      3328
#define XB_TOPGEN   3392
#define XCD_BAR_WORDS 3456
#define XB_SPIN_CAP (1u << 18)
DEV unsigned xb_ld(unsigned* p)              { return __hip_atomic_load(p, __ATOMIC_RELAXED, __HIP_MEMORY_SCOPE_AGENT); }
DEV unsigned xb_add(unsigned* p, unsigned v) { return __hip_atomic_fetch_add(p, v, __ATOMIC_RELAXED, __HIP_MEMORY_SCOPE_AGENT); }
DEV unsigned xb_xcc_id() { return (unsigned)__builtin_amdgcn_s_getreg((3 << 11) | 20) & 0xFu; }
#define XB_SPIN(cond, bar) do { unsigned _sp = 0; while (cond) { __builtin_amdgcn_s_sleep(1); \
    if ((++_sp & 255u) == 0u) { if (xb_ld(&(bar)[XB_TMO])) break; if (_sp > XB_SPIN_CAP) { atomicAdd(&(bar)[XB_TMO], 1u); break; } } } } while (0)
struct XcdBarrier { unsigned* bar; unsigned x; volatile LAS unsigned* st; };
DEV XcdBarrier xcd_barrier_post(unsigned* bar, volatile LAS unsigned* st) {
    XcdBarrier b; b.bar = bar; b.x = xb_xcc_id(); b.st = st;
    if (threadIdx.x == 0) (void)xb_add(&bar[XB_XCNT(b.x)], 1u);
    return b;
}
DEV void xcd_barrier_complete(unsigned* bar, unsigned x, unsigned& nloc, unsigned& nx) {
    const unsigned G = gridDim.x * gridDim.y * gridDim.z;
    unsigned sum, cnt, mine, sp = 0u;
    for (;;) {
        sum = 0u; cnt = 0u; mine = 0u;
#pragma unroll
        for (unsigned j = 0; j < 16; ++j) { const unsigned c = xb_ld(&bar[XB_XCNT(j)]); sum += c; cnt += (c > 0u) ? 1u : 0u; mine = (j == x) ? c : mine; }
        if (sum == G) break;
        __builtin_amdgcn_s_sleep(1);
        if ((++sp & 255u) == 0u) { if (xb_ld(&bar[XB_TMO])) break; if (sp > XB_SPIN_CAP) { atomicAdd(&bar[XB_TMO], 1u); break; } }
    }
    nloc = mine > 0u ? mine : 1u; nx = cnt > 0u ? cnt : 1u;
}
DEV void xcd_barrier(const XcdBarrier& b) {
    asm volatile("s_waitcnt vmcnt(0)" ::: "memory");
    __syncthreads();
    if (threadIdx.x == 0) {
        unsigned* bar = b.bar;
        __builtin_amdgcn_s_waitcnt(0);
        unsigned nloc = b.st[0], nx = b.st[1];
        if (nloc == 0u) { xcd_barrier_complete(bar, b.x, nloc, nx); b.st[0] = nloc; b.st[1] = nx; }
        const unsigned old = xb_add(&bar[XB_XSUB(b.x)], 1u);
        const unsigned gen = old / nloc;
        if (old + 1u == (gen + 1u) * nloc) {
            __builtin_amdgcn_fence(__ATOMIC_RELEASE, "agent");
            asm volatile("s_waitcnt vmcnt(0)" ::: "memory");
            const unsigned og = xb_add(&bar[XB_TOP], 1u);
            const unsigned tg = og / nx;
            if (og + 1u == (tg + 1u) * nx) xb_add(&bar[XB_TOPGEN], 1u);
            else XB_SPIN(xb_ld(&bar[XB_TOPGEN]) == tg, bar);
            __builtin_amdgcn_fence(__ATOMIC_ACQUIRE, "agent");
            xb_add(&bar[XB_XGEN(b.x)], 1u);
            asm volatile("s_waitcnt vmcnt(0)" ::: "memory");
        } else {
            XB_SPIN(xb_ld(&bar[XB_XGEN(b.x)]) == gen, bar);
            __builtin_amdgcn_fence(__ATOMIC_ACQUIRE, "agent");
            asm volatile("s_waitcnt vmcnt(0)" ::: "memory");
        }
    }
    __syncthreads();
}

DEV void transpose_item(const float* W, int N, int k0, int n0, bf16* dst, int ldk, LAS float* scr, int lane) {
#pragma unroll 8
    for (int i = 0; i < 32; ++i) { const int kk = 2 * i + (lane >> 5); scr[kk * 33 + (lane & 31)] = W[(size_t)(k0 + kk) * N + n0 + (lane & 31)]; }
    asm volatile("s_waitcnt lgkmcnt(0)" ::: "memory");
    const int c = lane & 7;
#pragma unroll
    for (int j = 0; j < 4; ++j) { const int n = (lane >> 3) + 8 * j; const LAS float* s = scr + (8 * c) * 33 + n;
        v4u o; o.x = pk2(s[0 * 33], s[1 * 33]); o.y = pk2(s[2 * 33], s[3 * 33]); o.z = pk2(s[4 * 33], s[5 * 33]); o.w = pk2(s[6 * 33], s[7 * 33]);
        *(v4u*)(dst + (size_t)n * ldk + k0 + 8 * c) = o; }
    asm volatile("s_waitcnt lgkmcnt(0)" ::: "memory");
}
DEV void ph_prep1(const float* w_in, const float* w_out, const float* rgw, const float* rew, const float* g2, const float* w_up, const float* a_up, const float* g_up, bf16* win_t, bf16* wout_t, float* wrt, bf16* lora, LAS float* scr, int gw, int NGW, int lane) {
    for (int i = gw * 64 + lane; i < 512 * 256; i += NGW * 64) { const int c = i >> 8, j = i & 255;
        if (j < 64) lora[c * 64 + j] = (bf16)f2bf(w_up[j * DR + c]); else if (j < 128) lora[512 * 64 + c * 64 + (j - 64)] = (bf16)f2bf(a_up[(j - 64) * DR + c]); else lora[2 * 512 * 64 + c * 128 + (j - 128)] = (bf16)f2bf(g_up[(j - 128) * DR + c]); }
    constexpr int I_IN = (D / 64) * (DIN / 32), I_OUT = (D / 64) * (D / 32);
    for (int it = gw; it < I_IN + I_OUT; it += NGW) {
        if (it < I_IN) { const int nblk = DIN / 32, kb = it / nblk, nb = it % nblk; transpose_item(w_in, DIN, 64 * kb, 32 * nb, win_t + (size_t)(32 * nb) * D, D, scr, lane); }
        else { const int r = it - I_IN, nblk = D / 32, kb = r / nblk, nb = r % nblk; transpose_item(w_out, D, 64 * kb, 32 * nb, wout_t + (size_t)(32 * nb) * D, D, scr, lane); }
    }
    for (int i = gw * 64 + lane; i < 48 * 1024; i += NGW * 64) { const int e = i >> 10, d = i & 1023; wrt[i] = e < 32 ? rew[d * 32 + e] * g2[d] : (e < 36 ? rgw[d * 4 + (e - 32)] * g2[d] : 0.f); }
}
DEV void ph_prep2(const float* wg, const float* wu, const float* wd, bf16* wgu_t, bf16* wd_t, LAS float* scr, int gw, int NGW, int lane) {
    constexpr int I_G = (D / 64) * (DE / 32), I_D = (DE / 64) * (D / 32), PER_E = 2 * I_G + I_D;
    for (int it = gw; it < NE * PER_E; it += NGW) {
        const int e = it / PER_E; int r = it % PER_E;
        if (r < 2 * I_G) { const int up = r >= I_G; if (up) r -= I_G; const int nblk = DE / 32, kb = r / nblk, nb = r % nblk, n0 = 32 * nb;
            const float* W = (up ? wu : wg) + (size_t)e * D * DE;
            bf16* dst = wgu_t + ((size_t)e * 1024 + (n0 >> 7) * 256 + up * 128 + (n0 & 127)) * D;
            transpose_item(W, DE, 64 * kb, n0, dst, D, scr, lane); }
        else { r -= 2 * I_G; const int nblk = D / 32, kb = r / nblk, nb = r % nblk, n0 = 32 * nb;
            transpose_item(wd + (size_t)e * DE * D, D, 64 * kb, n0, wd_t + ((size_t)e * D + n0) * DE, DE, scr, lane); }
    }
}
DEV void ph_rmsnorm(const float* x, const float* g, bf16* out, int gw, int NGW, int lane) {
    for (int row = gw; row < T; row += NGW) {
        const f32x4* xr = (const f32x4*)(x + (size_t)row * D) + lane; const f32x4* gr = (const f32x4*)g + lane;
        f32x4 v[4]; float s = 0.f;
#pragma unroll
        for (int j = 0; j < 4; ++j) { v[j] = xr[64 * j]; s += (v[j].x * v[j].x + v[j].y * v[j].y) + (v[j].z * v[j].z + v[j].w * v[j].w); }
        const float rstd = rsqrtf(wave_sum(s) * (1.f / D) + RMS_EPS);
        unsigned long long* o8 = (unsigned long long*)(out + (size_t)row * D) + lane;
#pragma unroll
        for (int j = 0; j < 4; ++j) { const f32x4 gg = gr[64 * j]; o8[64 * j] = (unsigned long long)pk2(v[j].x * rstd * gg.x, v[j].y * rstd * gg.y) | ((unsigned long long)pk2(v[j].z * rstd * gg.z, v[j].w * rstd * gg.w) << 32); }
    }
}

typedef short bf16x8 __attribute__((ext_vector_type(8)));
typedef short bf16x4 __attribute__((ext_vector_type(4)));
typedef unsigned u32x2 __attribute__((ext_vector_type(2)));
DEV f32x4 mfma16(bf16x8 f, bf16x8 g, f32x4 c) { return __builtin_amdgcn_mfma_f32_16x16x32_bf16(f, g, c, 0, 0, 0); }
DEV unsigned cvtpk(float lo, float hi) { return cvt_pk_bf16(lo, hi); }
DEV bf16x8 ldfrag(const LAS unsigned char* base, int row, int stride, int kbyte) { return *(const LAS bf16x8*)(base + row * stride + kbyte); }
constexpr int SA64 = 144, SA128 = 272;
constexpr int CH = 64, NCH = SEQ / CH;

constexpr int HU_QH = 0, HU_OT = 16384, HU_UT = 32768, HU_BYTES = 65536;
constexpr int HL_QT = 0, HL_KT = 17408, HL_KHT = 34816, HL_VT = 53248, HL_SC = 71680, HL_PFX = 80896;
DEV void hgrn_unitA(int unit, const bf16* p, const float* cw, const float* lbl, unsigned char* iah, float* dch, bf16* mix, LAS unsigned char* lds, int tid) {
    const int c = unit & 31, h = (unit >> 5) & 3, b = unit >> 7;
    const int lane = tid & 63, wave = tid >> 6, q16 = lane & 15, g4 = lane >> 4;
    const size_t trow0 = (size_t)b * SEQ + (size_t)c * CH;
    unsigned char* uo = iah + (size_t)unit * HU_BYTES;
    LAS float* pfx = (LAS float*)(lds + HL_PFX);
    const int cc = tid & 15, run = tid >> 4, c0 = 8 * cc, tl = 2 * run;
    float qv[2][8], lfv[2][8], khv[2][8];
    {
        v4u rq[5], rf[5];
#pragma unroll
        for (int i = 0; i < 5; ++i) { const int sl = c * CH + tl - 3 + i;
            if (sl >= 0) { const bf16* row = p + (trow0 + tl - 3 + i) * DIN + DRIN + h * 128 + c0; rq[i] = *(const v4u*)row; rf[i] = *(const v4u*)(row + 512); }
            else { rq[i] = (v4u){0u, 0u, 0u, 0u}; rf[i] = (v4u){0u, 0u, 0u, 0u}; } }
#pragma unroll
        for (int e = 0; e < 8; ++e) {
            const int col = h * 128 + c0 + e;
            float wq[4], wf[4];
#pragma unroll
            for (int j = 0; j < 4; ++j) { wq[j] = cw[j * 1536 + col]; wf[j] = cw[j * 1536 + 512 + col]; }
            const float lb = 1.f / (1.f + __expf(lbl[512 + col] - lbl[col]));
            float xq[5], xf[5];
#pragma unroll
            for (int i = 0; i < 5; ++i) { const unsigned wq_ = rq[i][e >> 1], wf_ = rf[i][e >> 1];
                xq[i] = (e & 1) ? __uint_as_float(wq_ & 0xffff0000u) : __uint_as_float(wq_ << 16);
                xf[i] = (e & 1) ? __uint_as_float(wf_ & 0xffff0000u) : __uint_as_float(wf_ << 16); }
#pragma unroll
            for (int tt = 0; tt < 2; ++tt) {
                const float aq = wq[0] * xq[tt] + wq[1] * xq[tt + 1] + wq[2] * xq[tt + 2] + wq[3] * xq[tt + 3];
                const float af = wf[0] * xf[tt] + wf[1] * xf[tt + 1] + wf[2] * xf[tt + 2] + wf[3] * xf[tt + 3];
                const float fg = lb + (1.f - lb) * sigmoidf_(af);
                qv[tt][e] = aq * sigmoidf_(aq); lfv[tt][e] = __logf(fg); khv[tt][e] = 1.f - fg; }
            pfx[run * 128 + c0 + e] = lfv[0][e] + lfv[1][e];
        }
    }
    __syncthreads();
    if (tid < 128) { float a = 0.f;
#pragma unroll 8
        for (int r = 0; r < 32; ++r) { const float v = pfx[r * 128 + tid]; pfx[r * 128 + tid] = a; a += v; }
        pfx[32 * 128 + tid] = a; }
    __syncthreads();
    {
        unsigned qt[2][4], kt[2][4], qh[2][4];
#pragma unroll
        for (int e = 0; e < 8; ++e) {
            const int k = c0 + e;
            const float base = pfx[run * 128 + k], ref = pfx[16 * 128 + k], tot = pfx[32 * 128 + k];
            const float eref = __expf(ref), etr = __expf(tot - ref);
            float val_qt[2], val_kt[2], val_qh[2], val_kh[2];
            float bc = base;
#pragma unroll
            for (int tt = 0; tt < 2; ++tt) { bc += lfv[tt][e]; const float E = __expf(bc - ref), Ei = __builtin_amdgcn_rcpf(E);
                val_qt[tt] = qv[tt][e] * E; val_kt[tt] = khv[tt][e] * Ei; val_qh[tt] = val_qt[tt] * eref; val_kh[tt] = val_kt[tt] * etr; }
            *(LAS unsigned*)(lds + HL_KHT + k * SA64 + tl * 2) = cvtpk(val_kh[0], val_kh[1]);
            if (e & 1) {
#pragma unroll
                for (int tt = 0; tt < 2; ++tt) { qt[tt][e >> 1] = (qt[tt][e >> 1] & 0xffffu) | (f2bf(val_qt[tt]) << 16); kt[tt][e >> 1] = (kt[tt][e >> 1] & 0xffffu) | (f2bf(val_kt[tt]) << 16); qh[tt][e >> 1] = (qh[tt][e >> 1] & 0xffffu) | (f2bf(val_qh[tt]) << 16); }
            } else {
#pragma unroll
                for (int tt = 0; tt < 2; ++tt) { qt[tt][e >> 1] = f2bf(val_qt[tt]); kt[tt][e >> 1] = f2bf(val_kt[tt]); qh[tt][e >> 1] = f2bf(val_qh[tt]); }
            }
            if (run == 0) dch[(size_t)unit * 128 + k] = __expf(tot);
        }
#pragma unroll
        for (int tt = 0; tt < 2; ++tt) {
            *(LAS v4u*)(lds + HL_QT + (tl + tt) * SA128 + c0 * 2) = (v4u){qt[tt][0], qt[tt][1], qt[tt][2], qt[tt][3]};
            *(LAS v4u*)(lds + HL_KT + (tl + tt) * SA128 + c0 * 2) = (v4u){kt[tt][0], kt[tt][1], kt[tt][2], kt[tt][3]};
            { const int t = tl + tt, o32 = c0 & 31, ksq = c0 >> 5, half = o32 >> 4, gq = (o32 & 15) >> 2;
              unsigned char* qb = uo + HU_QH + (((t >> 4) * 4 + ksq) * 64 + (t & 15)) * 16 + half * 8;
              *(u32x2*)(qb + gq * 256) = (u32x2){qh[tt][0], qh[tt][1]}; *(u32x2*)(qb + (gq + 1) * 256) = (u32x2){qh[tt][2], qh[tt][3]}; }
        }
    }
    {
        v4u ri[5];
#pragma unroll
        for (int i = 0; i < 5; ++i) { const int sl = c * CH + tl - 3 + i;
            if (sl >= 0) ri[i] = *(const v4u*)(p + (trow0 + tl - 3 + i) * DIN + DRIN + 1024 + h * 128 + c0); else ri[i] = (v4u){0u, 0u, 0u, 0u}; }
#pragma unroll
        for (int e = 0; e < 8; ++e) {
            const int col = h * 128 + c0 + e;
            float wi[4], xi[5];
#pragma unroll
            for (int j = 0; j < 4; ++j) wi[j] = cw[j * 1536 + 1024 + col];
#pragma unroll
            for (int i = 0; i < 5; ++i) { const unsigned w_ = ri[i][e >> 1]; xi[i] = (e & 1) ? __uint_as_float(w_ & 0xffff0000u) : __uint_as_float(w_ << 16); }
            const float v0 = wi[0] * xi[0] + wi[1] * xi[1] + wi[2] * xi[2] + wi[3] * xi[3], v1 = wi[0] * xi[1] + wi[1] * xi[2] + wi[2] * xi[3] + wi[3] * xi[4];
            *(LAS unsigned*)(lds + HL_VT + (c0 + e) * SA64 + tl * 2) = cvtpk(v0, v1);
        }
#pragma unroll
        for (int tt = 0; tt < 2; ++tt) { const v4u gr = *(const v4u*)(p + (trow0 + tl + tt) * DIN + DRIN + 1536 + h * 128 + c0); unsigned o[4];
#pragma unroll
            for (int e2 = 0; e2 < 4; ++e2) { const float g0 = __uint_as_float(gr[e2] << 16), g1 = __uint_as_float(gr[e2] & 0xffff0000u); o[e2] = cvtpk(g0 * sigmoidf_(g0), g1 * sigmoidf_(g1)); }
            *(v4u*)(mix + (trow0 + tl + tt) * D + 512 + h * 128 + c0) = (v4u){o[0], o[1], o[2], o[3]}; }
    }
    __syncthreads();
    for (int ti = wave; ti < 16; ti += 8) {
        const int mt = ti >> 2, nt = ti & 3;
        f32x4 acc = (f32x4){0.f, 0.f, 0.f, 0.f};
        if (nt <= mt) {
#pragma unroll
            for (int ks = 0; ks < 4; ++ks) acc = mfma16(ldfrag(lds + HL_KT, 16 * nt + q16, SA128, ks * 64 + g4 * 16), ldfrag(lds + HL_QT, 16 * mt + q16, SA128, ks * 64 + g4 * 16), acc);
            if (nt == mt) {
#pragma unroll
                for (int r = 0; r < 4; ++r) if (4 * g4 + r > q16) acc[r] = 0.f; }
        }
        *(LAS u32x2*)(lds + HL_SC + (16 * mt + q16) * SA64 + (16 * nt + 4 * g4) * 2) = (u32x2){cvtpk(acc[0], acc[1]), cvtpk(acc[2], acc[3])};
    }
    __syncthreads();
    {
        const int vrow = 16 * wave + q16;
        const bf16x8 vf0 = ldfrag(lds + HL_VT, vrow, SA64, g4 * 16), vf1 = ldfrag(lds + HL_VT, vrow, SA64, 64 + g4 * 16);
#pragma unroll
        for (int mt = 0; mt < 4; ++mt) {
            f32x4 acc = (f32x4){0.f, 0.f, 0.f, 0.f};
            acc = mfma16(ldfrag(lds + HL_SC, 16 * mt + q16, SA64, g4 * 16), vf0, acc);
            acc = mfma16(ldfrag(lds + HL_SC, 16 * mt + q16, SA64, 64 + g4 * 16), vf1, acc);
            *(u32x2*)(uo + HU_OT + ((wave * 64 + lane) * 4 + mt) * 8) = (u32x2){cvtpk(acc[0], acc[1]), cvtpk(acc[2], acc[3])};
        }
#pragma unroll
        for (int kt = 0; kt < 8; ++kt) {
            f32x4 acc = (f32x4){0.f, 0.f, 0.f, 0.f};
            acc = mfma16(ldfrag(lds + HL_KHT, 16 * kt + q16, SA64, g4 * 16), vf0, acc);
            acc = mfma16(ldfrag(lds + HL_KHT, 16 * kt + q16, SA64, 64 + g4 * 16), vf1, acc);
            *(u32x2*)(uo + HU_UT + ((wave * 64 + lane) * 8 + kt) * 8) = (u32x2){cvtpk(acc[0], acc[1]), cvtpk(acc[2], acc[3])};
        }
    }
    __syncthreads();
}

DEV void blob_to_lds(const unsigned char* src, LAS unsigned char* dst, int bytes, int wave, int lane) {
    for (int j = wave; j < bytes / 1024; j += NWAVES) __builtin_amdgcn_global_load_lds((const unsigned*)(src + j * 1024 + lane * 16), (LAS unsigned*)(dst + j * 1024), 16, 0, 0);
}
DEV void hgrn_seqB(int bh, const unsigned char* iah, const float* dch, const float* ng, bf16* mix, LAS unsigned char* lds, int tid) {
    const int lane = tid & 63, wave = __builtin_amdgcn_readfirstlane(tid >> 6), q16 = lane & 15, g4 = lane >> 4;
    const int h = bh & 3, b = bh >> 2, v = 16 * wave + q16;
    const float gain = ng[h * 128 + v];
    LAS float* dls = (LAS float*)(lds + 2 * HU_BYTES); LAS float* red = dls + 256;
    f32x4 S[8];
#pragma unroll
    for (int i = 0; i < 8; ++i) S[i] = (f32x4){0.f, 0.f, 0.f, 0.f};
    blob_to_lds(iah + (size_t)(bh * NCH) * HU_BYTES, lds, HU_BYTES, wave, lane);
    if (tid < 128) dls[tid] = dch[(size_t)(bh * NCH) * 128 + tid];
    asm volatile("s_waitcnt vmcnt(0)" ::: "memory");
    __syncthreads();
    for (int c = 0; c < NCH; ++c) {
        const LAS unsigned char* bl = lds + (c & 1) * HU_BYTES;
        const size_t trow0 = (size_t)b * SEQ + (size_t)c * CH;
        float dnext = 0.f;
        if (c + 1 < NCH) { blob_to_lds(iah + (size_t)(bh * NCH + c + 1) * HU_BYTES, lds + ((c + 1) & 1) * HU_BYTES, HU_BYTES, wave, lane);
            if (tid < 128) dnext = dch[(size_t)(bh * NCH + c + 1) * 128 + tid]; }
        float gate[4][4];
#pragma unroll
        for (int mt = 0; mt < 4; ++mt)
#pragma unroll
            for (int r = 0; r < 4; ++r) gate[mt][r] = bf2f(mix[(trow0 + 16 * mt + 4 * g4 + r) * D + 512 + h * 128 + v]);
        bf16x8 sb[4];
#pragma unroll
        for (int ks = 0; ks < 4; ++ks) { const v4u t4 = (v4u){cvt_pk_bf16(S[2 * ks][0], S[2 * ks][1]), cvt_pk_bf16(S[2 * ks][2], S[2 * ks][3]), cvt_pk_bf16(S[2 * ks + 1][0], S[2 * ks + 1][1]), cvt_pk_bf16(S[2 * ks + 1][2], S[2 * ks + 1][3])};
            sb[ks] = __builtin_bit_cast(bf16x8, t4); }
        f32x4 o[4];
        const LAS unsigned char* myo = bl + HU_OT + (wave * 64 + lane) * 32, *myu = bl + HU_UT + (wave * 64 + lane) * 64;
#pragma unroll
        for (int mt = 0; mt < 4; ++mt) {
            const u32x2 oi = *(const LAS u32x2*)(myo + mt * 8);
            f32x4 acc = (f32x4){bflo(oi.x), bfhi(oi.x), bflo(oi.y), bfhi(oi.y)};
#pragma unroll
            for (int ks = 0; ks < 4; ++ks) acc = mfma16(*(const LAS bf16x8*)(bl + HU_QH + ((mt * 4 + ks) * 64 + lane) * 16), sb[ks], acc);
            o[mt] = acc;
        }
        const LAS float* dl = dls + (c & 1) * 128;
#pragma unroll
        for (int i = 0; i < 8; ++i) {
            const f32x4 d = *(const LAS f32x4*)(dl + 16 * i + 4 * g4);
            const u32x2 uu = *(const LAS u32x2*)(myu + i * 8);
            S[i][0] = S[i][0] * d[0] + bflo(uu.x); S[i][1] = S[i][1] * d[1] + bfhi(uu.x); S[i][2] = S[i][2] * d[2] + bflo(uu.y); S[i][3] = S[i][3] * d[3] + bfhi(uu.y);
        }
        LAS float* rw = red + (c & 1) * 512;
#pragma unroll
        for (int mt = 0; mt < 4; ++mt)
#pragma unroll
            for (int r = 0; r < 4; ++r) { float s = o[mt][r] * o[mt][r]; s += __shfl_xor(s, 1); s += __shfl_xor(s, 2); s += __shfl_xor(s, 4); s += __shfl_xor(s, 8);
                if (q16 == 0) rw[(16 * mt + 4 * g4 + r) * 8 + wave] = s; }
        __syncthreads();
#pragma unroll
        for (int mt = 0; mt < 4; ++mt)
#pragma unroll
            for (int r = 0; r < 4; ++r) { const int t = 16 * mt + 4 * g4 + r;
                const LAS f32x4* rp = (const LAS f32x4*)(rw + t * 8); const f32x4 r0 = rp[0], r1 = rp[1];
                const float ms = ((r0[0] + r0[1]) + (r0[2] + r0[3]) + (r1[0] + r1[1]) + (r1[2] + r1[3])) * (1.f / 128.f);
                mix[(trow0 + t) * D + 512 + h * 128 + v] = (bf16)f2bf(o[mt][r] * rsqrtf(ms + RMS_EPS) * gain * gate[mt][r]); }
        if (c + 1 < NCH && tid < 128) dls[((c + 1) & 1) * 128 + tid] = dnext;
        asm volatile("s_waitcnt vmcnt(0)" ::: "memory");
        __syncthreads();
    }
}
constexpr int RU_L = 0, RU_RM = 8192, RU_NT = 16384, RU_YT = 24576, RU_G = 32768, RU_VB = 40960, RU_BYTES = 49152;
constexpr int RL_TDW = 0, RL_DA = 9216, RL_SDG = 18432;
constexpr int RL_A = 0, RL_CUM = 17408;
constexpr int RL_AAK = 0, RL_ARB = 9216, RL_ARK = 18432;
constexpr int RL_RAW = 36864, RAW_STRIDE = 400;
constexpr int RL_X2 = 36864;
constexpr int RL_AAB = 62976;
constexpr int RL_AT = 79360, RL_BT = 88576, RL_KT = 97792, RL_RT = 107008;
constexpr int RL_WT = RL_BT, RL_UT = RL_KT;
constexpr int RL_BHT = 116224, RL_KHT = 125440, RL_VT = 134656;
constexpr int RL_SEG = 143872;
constexpr int FS = 272;


constexpr int RL_ULDS = 145920;
#ifndef PROBE_STAGE
#define PROBE_STAGE 0
#endif
#define PROBE_AMP 8
#define STAGE_T0(k) unsigned long long t0_##k = 0; if (PROBE_STAGE == (k)) t0_##k = __builtin_amdgcn_s_memrealtime()
#define STAGE_T1(k) if (PROBE_STAGE == (k)) tacc += __builtin_amdgcn_s_memrealtime() - t0_##k
DEV void sub_solve(LAS unsigned char* lds, int lane, int wave) {
    LAS unsigned char* pu = lds + (wave == 0 ? RL_ULDS : RL_X2) + lane * 4; const int us = wave == 0 ? 256 : FS;
    LAS unsigned char* pw = lds + (wave == 0 ? RL_WT : RL_UT) + lane * SA64;
#pragma nounroll
    for (int I = 0; I < 8; ++I) {
        LAS unsigned char* pa = lds + RL_AAB + 8 * I * 256;
        float xa[8];
        if (wave == 0) {
#pragma unroll
            for (int r = 0; r < 8; ++r) xa[r] = bf2f(*(const LAS bf16*)(lds + RL_AT + (8 * I + r) * SA64 + lane * 2));
        } else {
#pragma unroll
            for (int r = 0; r < 8; ++r) xa[r] = *(const LAS float*)(lds + RL_X2 + (8 * I + r) * FS + lane * 4);
        }
#pragma nounroll
        for (int J = 0; J < I; ++J) {
            float uj[8];
#pragma unroll
            for (int s2 = 0; s2 < 8; ++s2) uj[s2] = *(const LAS float*)(pu + (8 * J + s2) * us);
#pragma unroll
            for (int r = 0; r < 8; ++r)
#pragma unroll
                for (int s4 = 0; s4 < 2; ++s4) { const f32x4 a4 = *(const LAS f32x4*)(pa + r * 256 + (8 * J + 4 * s4) * 4);
                    xa[r] += a4[0] * uj[4 * s4] + a4[1] * uj[4 * s4 + 1] + a4[2] * uj[4 * s4 + 2] + a4[3] * uj[4 * s4 + 3]; }
        }
        const LAS unsigned char* pd = pa + 8 * I * 4;
#pragma unroll
        for (int r = 1; r < 8; ++r)
#pragma unroll
            for (int s4 = 0; s4 < 2; ++s4) if (4 * s4 < r) { const f32x4 a4 = *(const LAS f32x4*)(pd + r * 256 + s4 * 16);
#pragma unroll
                for (int e = 0; e < 4; ++e) if (4 * s4 + e < r) xa[r] += a4[e] * xa[4 * s4 + e]; }
#pragma unroll
        for (int r = 0; r < 8; ++r) *(LAS float*)(pu + (8 * I + r) * us) = xa[r];
        *(LAS v4u*)(pw + I * 16) = (v4u){cvt_pk_bf16(xa[0], xa[1]), cvt_pk_bf16(xa[2], xa[3]), cvt_pk_bf16(xa[4], xa[5]), cvt_pk_bf16(xa[6], xa[7])};
    }
}

DEV void rwkv_unitA(int unit, const bf16* p, const float* mu, const float* w0, const float* a0, const float* k_k, const float* k_a, const float* r_k,
                    const bf16* wupT, const bf16* aupT, const bf16* gupT, unsigned char* iar, float* gcr, LAS unsigned char* lds, int tid0, unsigned long long& tacc) {
    const int c = unit & 31, h = (unit >> 5) & 7, b = unit >> 8;
    const size_t trow0 = (size_t)b * SEQ + (size_t)c * CH;
    unsigned char* uo = iar + (size_t)unit * RU_BYTES;
    STAGE_T0(1);
    { int tid = tid0; asm volatile("" : "+v"(tid)); const int lane = tid & 63, wave = __builtin_amdgcn_readfirstlane(tid >> 6), q16 = lane & 15, g4 = lane >> 4; (void)lane; (void)wave; (void)q16; (void)g4;
    {
        v4u rawv[4], curv[4], prvv[4];
#pragma unroll
        for (int i = 0; i < 4; ++i) { const int it = tid + i * NTHR, row = it / 24, ch8 = it % 24, part = ch8 >> 3, cc = ch8 & 7;
            rawv[i] = (v4u){0u, 0u, 0u, 0u};
            if (it < 65 * 24 && (row > 0 || c > 0)) rawv[i] = *(const v4u*)(p + (trow0 + row - 1) * DIN + part * 512 + h * 64 + cc * 8); }
#pragma unroll
        for (int i = 0; i < 4; ++i) { const int it = tid + i * NTHR, t = it >> 5, ch8 = it & 31;
            const bf16* src = p + (trow0 + t) * DIN + 1536 + ch8 * 8;
            curv[i] = *(const v4u*)src; prvv[i] = (v4u){0u, 0u, 0u, 0u};
            if (t > 0 || c > 0) prvv[i] = *(const v4u*)(src - DIN); }
#pragma unroll
        for (int i = 0; i < 4; ++i) { const int it = tid + i * NTHR, row = it / 24, ch8 = it % 24;
            if (it < 65 * 24) *(LAS v4u*)(lds + RL_RAW + row * RAW_STRIDE + ch8 * 16) = rawv[i]; }
#pragma unroll
        for (int i = 0; i < 4; ++i) { const int it = tid + i * NTHR, t = it >> 5, ch8 = it & 31;
            const v4u cur = curv[i], prv = prvv[i];
            unsigned o[4];
#pragma unroll
            for (int e2 = 0; e2 < 4; ++e2) { const int col = 1536 + ch8 * 8 + 2 * e2;
                float x0 = bflo(cur[e2]), x1 = bfhi(cur[e2]); x0 += mu[col] * (bflo(prv[e2]) - x0); x1 += mu[col + 1] * (bfhi(prv[e2]) - x1);
                if (ch8 < 8) { x0 = tanhf(x0); x1 = tanhf(x1); } else if (ch8 >= 16) { x0 = sigmoidf_(x0); x1 = sigmoidf_(x1); }
                o[e2] = cvt_pk_bf16(x0, x1); }
            LAS unsigned char* dst = ch8 < 8 ? lds + RL_TDW + t * SA64 + ch8 * 16 : (ch8 < 16 ? lds + RL_DA + t * SA64 + (ch8 - 8) * 16 : lds + RL_SDG + t * SA128 + (ch8 - 16) * 16);
            *(LAS v4u*)dst = (v4u){o[0], o[1], o[2], o[3]}; }
    }
    __syncthreads();
    }
    STAGE_T1(1);
    STAGE_T0(2);
    { int tid = tid0; asm volatile("" : "+v"(tid)); const int lane = tid & 63, wave = __builtin_amdgcn_readfirstlane(tid >> 6), q16 = lane & 15, g4 = lane >> 4; (void)lane; (void)wave; (void)q16; (void)g4;
    {
        const int mt = wave >> 1;
        f32x4 zw[2], za[2], zg[2];
#pragma unroll
        for (int j = 0; j < 2; ++j) { const int nt = 2 * (wave & 1) + j; const int chrow = h * 64 + 16 * nt + q16;
            f32x4 aw = (f32x4){0.f, 0.f, 0.f, 0.f}, aa = aw, ag = aw;
#pragma unroll
            for (int ks = 0; ks < 2; ++ks) {
                aw = mfma16(*(const bf16x8*)(wupT + chrow * 64 + ks * 32 + g4 * 8), ldfrag(lds + RL_TDW, 16 * mt + q16, SA64, ks * 64 + g4 * 16), aw);
                aa = mfma16(*(const bf16x8*)(aupT + chrow * 64 + ks * 32 + g4 * 8), ldfrag(lds + RL_DA, 16 * mt + q16, SA64, ks * 64 + g4 * 16), aa); }
#pragma unroll
            for (int ks = 0; ks < 4; ++ks) ag = mfma16(ldfrag(lds + RL_SDG, 16 * mt + q16, SA128, ks * 64 + g4 * 16), *(const bf16x8*)(gupT + chrow * 128 + ks * 32 + g4 * 8), ag);
            zw[j] = aw; za[j] = aa; zg[j] = ag; }
        __syncthreads();
#pragma unroll
        for (int j = 0; j < 2; ++j) { const int nt = 2 * (wave & 1) + j, t = 16 * mt + q16, ch = 16 * nt + 4 * g4;
            const f32x4 w0v = *(const f32x4*)(w0 + h * 64 + ch), a0v = *(const f32x4*)(a0 + h * 64 + ch);
            f32x4 ldv, av;
#pragma unroll
            for (int r = 0; r < 4; ++r) { const float nz = -(zw[j][r] + w0v[r]), sp = fmaxf(nz, 0.f) + log1pf(__expf(-fabsf(nz)));
                ldv[r] = -__expf(-sp - 0.5f); av[r] = sigmoidf_(za[j][r] + a0v[r]); }
            *(LAS f32x4*)(lds + RL_CUM + t * FS + ch * 4) = ldv; *(LAS f32x4*)(lds + RL_A + t * FS + ch * 4) = av;
            *(u32x2*)(uo + RU_G + ((nt * 64 + lane) * 4 + mt) * 8) = (u32x2){cvt_pk_bf16(zg[j][0], zg[j][1]), cvt_pk_bf16(zg[j][2], zg[j][3])}; }
    }
    __syncthreads();
    }
    STAGE_T1(2);
    STAGE_T0(3);
    { int tid = tid0; asm volatile("" : "+v"(tid)); const int lane = tid & 63, wave = __builtin_amdgcn_readfirstlane(tid >> 6), q16 = lane & 15, g4 = lane >> 4; (void)lane; (void)wave; (void)q16; (void)g4;
    {
        const int ch = tid & 63, seg = tid >> 6; LAS float* segt = (LAS float*)(lds + RL_SEG);
        float loc[8]; float a = 0.f;
#pragma unroll
        for (int i = 0; i < 8; ++i) { a += *(LAS float*)(lds + RL_CUM + (8 * seg + i) * FS + ch * 4); loc[i] = a; }
        segt[seg * 64 + ch] = a;
        __syncthreads();
        float off = 0.f;
#pragma unroll
        for (int s2 = 0; s2 < 7; ++s2) if (s2 < seg) off += segt[s2 * 64 + ch];
#pragma unroll
        for (int i = 0; i < 8; ++i) *(LAS float*)(lds + RL_CUM + (8 * seg + i) * FS + ch * 4) = loc[i] + off;
    }
    __syncthreads();
    }
    STAGE_T1(3);
    STAGE_T0(4);
    { int tid = tid0; asm volatile("" : "+v"(tid)); const int lane = tid & 63, wave = __builtin_amdgcn_readfirstlane(tid >> 6), q16 = lane & 15, g4 = lane >> 4; (void)lane; (void)wave; (void)q16; (void)g4;
    {
        const int t = tid >> 3, ch0 = 8 * (tid & 7);
        const LAS unsigned char* rawc = lds + RL_RAW + (t + 1) * RAW_STRIDE, *rawp = lds + RL_RAW + t * RAW_STRIDE;
        float xr[8], xk[8], xv[8];
#pragma unroll
        for (int part = 0; part < 3; ++part) { const v4u cu = *(const LAS v4u*)(rawc + part * 128 + ch0 * 2), pv = *(const LAS v4u*)(rawp + part * 128 + ch0 * 2);
#pragma unroll
            for (int e2 = 0; e2 < 4; ++e2) { const int col = part * 512 + h * 64 + ch0 + 2 * e2;
                float x0 = bflo(cu[e2]), x1 = bfhi(cu[e2]); x0 += mu[col] * (bflo(pv[e2]) - x0); x1 += mu[col + 1] * (bfhi(pv[e2]) - x1);
                if (part == 0) { xr[2 * e2] = x0; xr[2 * e2 + 1] = x1; } else if (part == 1) { xk[2 * e2] = x0; xk[2 * e2 + 1] = x1; } else { xv[2 * e2] = x0; xv[2 * e2 + 1] = x1; } } }
        float kkp[8], ssq = 0.f;
#pragma unroll
        for (int e = 0; e < 8; ++e) { kkp[e] = xk[e] * k_k[h * 64 + ch0 + e]; ssq += kkp[e] * kkp[e]; }
        ssq += __shfl_xor(ssq, 1); ssq += __shfl_xor(ssq, 2); ssq += __shfl_xor(ssq, 4);
        const float inv = 1.f / fmaxf(sqrtf(ssq), L2_EPS);
        float bon = 0.f;
        unsigned oa[4], ob[4], ok[4], orr[4];
        float bh[8], kh[8];
#pragma unroll
        for (int e = 0; e < 8; ++e) { const int ch = ch0 + e;
            const float a = *(const LAS float*)(lds + RL_A + t * FS + ch * 4), cumt = *(const LAS float*)(lds + RL_CUM + t * FS + ch * 4);
            const float cump = t > 0 ? *(const LAS float*)(lds + RL_CUM + (t - 1) * FS + ch * 4) : 0.f, cumC = *(const LAS float*)(lds + RL_CUM + 63 * FS + ch * 4);
            const float kk = kkp[e] * inv, kp = xk[e] * (1.f + (a - 1.f) * k_a[h * 64 + ch]), bb = kk * a;
            const float E = __expf(cumt), Ei = __builtin_amdgcn_rcpf(E), Ep = __expf(cump), EC = __expf(cumC - cumt);
            const float vat = -kk * Ep, vbt = bb * Ei, vkt = kp * Ei, vrt = xr[e] * E;
            bh[e] = bb * EC; kh[e] = kp * EC;
            bon += xr[e] * kp * r_k[h * 64 + ch];
            if (e & 1) { oa[e >> 1] |= f2bf(vat) << 16; ob[e >> 1] |= f2bf(vbt) << 16; ok[e >> 1] |= f2bf(vkt) << 16; orr[e >> 1] |= f2bf(vrt) << 16; }
            else { oa[e >> 1] = f2bf(vat); ob[e >> 1] = f2bf(vbt); ok[e >> 1] = f2bf(vkt); orr[e >> 1] = f2bf(vrt); }
            if (t == 63) gcr[(size_t)unit * 64 + ch] = E;
        }
        *(LAS v4u*)(lds + RL_AT + t * SA64 + ch0 * 2) = (v4u){oa[0], oa[1], oa[2], oa[3]};
        *(LAS v4u*)(lds + RL_BT + t * SA64 + ch0 * 2) = (v4u){ob[0], ob[1], ob[2], ob[3]};
        *(LAS v4u*)(lds + RL_KT + t * SA64 + ch0 * 2) = (v4u){ok[0], ok[1], ok[2], ok[3]};
        *(LAS v4u*)(lds + RL_RT + t * SA64 + ch0 * 2) = (v4u){orr[0], orr[1], orr[2], orr[3]};
#pragma unroll
        for (int e = 0; e < 8; ++e) { *(LAS bf16*)(lds + RL_BHT + (ch0 + e) * SA64 + t * 2) = (bf16)f2bf(bh[e]); *(LAS bf16*)(lds + RL_KHT + (ch0 + e) * SA64 + t * 2) = (bf16)f2bf(kh[e]);
            *(LAS bf16*)(lds + RL_VT + (ch0 + e) * SA64 + t * 2) = (bf16)f2bf(xv[e]); }
        bon += __shfl_xor(bon, 1); bon += __shfl_xor(bon, 2); bon += __shfl_xor(bon, 4);
#pragma unroll
        for (int e = 0; e < 8; ++e) { const int ch = ch0 + e;
            *(bf16*)(uo + RU_VB + (((ch >> 4) * 64 + ((t & 15) >> 2) * 16 + (ch & 15)) * 4 + (t >> 4)) * 8 + (t & 3) * 2) = (bf16)f2bf(bon * xv[e]); }
    }
    __syncthreads();
    }
    STAGE_T1(4);
    STAGE_T0(5);
    { int tid = tid0; asm volatile("" : "+v"(tid)); const int lane = tid & 63, wave = __builtin_amdgcn_readfirstlane(tid >> 6), q16 = lane & 15, g4 = lane >> 4; (void)lane; (void)wave; (void)q16; (void)g4;
    for (int ti = wave; ti < 16; ti += 8) {
        const int mt = ti >> 2, nt = ti & 3;
        f32x4 ab = (f32x4){0.f, 0.f, 0.f, 0.f}, ak = ab, rb = ab, rk = ab;
        if (nt <= mt) {
#pragma unroll
            for (int ks = 0; ks < 2; ++ks) { const int kb = ks * 64 + g4 * 16;
                const bf16x8 fb = ldfrag(lds + RL_BT, 16 * nt + q16, SA64, kb), fk = ldfrag(lds + RL_KT, 16 * nt + q16, SA64, kb), ga = ldfrag(lds + RL_AT, 16 * mt + q16, SA64, kb), gr = ldfrag(lds + RL_RT, 16 * mt + q16, SA64, kb);
                ab = mfma16(fb, ga, ab); ak = mfma16(fk, ga, ak); rb = mfma16(fb, gr, rb); rk = mfma16(fk, gr, rk); }
            if (nt == mt) {
#pragma unroll
                for (int r = 0; r < 4; ++r) { if (4 * g4 + r >= q16) { ab[r] = 0.f; ak[r] = 0.f; } if (4 * g4 + r > q16) { rb[r] = 0.f; rk[r] = 0.f; } } }
        }
        const int t = 16 * mt + q16, s0 = 16 * nt + 4 * g4;
        *(LAS f32x4*)(lds + RL_AAB + t * 256 + s0 * 4) = ab;
        *(LAS u32x2*)(lds + RL_AAK + t * SA64 + s0 * 2) = (u32x2){cvt_pk_bf16(ak[0], ak[1]), cvt_pk_bf16(ak[2], ak[3])};
        *(LAS u32x2*)(lds + RL_ARB + t * SA64 + s0 * 2) = (u32x2){cvt_pk_bf16(rb[0], rb[1]), cvt_pk_bf16(rb[2], rb[3])};
        *(LAS u32x2*)(lds + RL_ARK + t * SA64 + s0 * 2) = (u32x2){cvt_pk_bf16(rk[0], rk[1]), cvt_pk_bf16(rk[2], rk[3])};
    }
    __syncthreads();
    }
    STAGE_T1(5);
    STAGE_T0(6);
    { int tid = tid0; asm volatile("" : "+v"(tid)); const int lane = tid & 63, wave = __builtin_amdgcn_readfirstlane(tid >> 6), q16 = lane & 15, g4 = lane >> 4; (void)lane; (void)wave; (void)q16; (void)g4;
    for (int ti = wave; ti < 16; ti += 8) {
        const int mt = ti >> 2, nt = ti & 3;
        f32x4 acc = (f32x4){0.f, 0.f, 0.f, 0.f};
#pragma unroll
        for (int ks = 0; ks < 2; ++ks) acc = mfma16(ldfrag(lds + RL_VT, 16 * nt + q16, SA64, ks * 64 + g4 * 16), ldfrag(lds + RL_AAK, 16 * mt + q16, SA64, ks * 64 + g4 * 16), acc);
        *(LAS f32x4*)(lds + RL_X2 + (16 * mt + q16) * FS + (16 * nt + 4 * g4) * 4) = acc;
    }
    __syncthreads();
    }
    STAGE_T1(6);
    STAGE_T0(7);
    { int tid = tid0; asm volatile("" : "+v"(tid)); const int lane = tid & 63, wave = __builtin_amdgcn_readfirstlane(tid >> 6), q16 = lane & 15, g4 = lane >> 4; (void)lane; (void)wave; (void)q16; (void)g4;
    if (wave < 2) sub_solve(lds, lane, wave);
    __syncthreads();
    }
    STAGE_T1(7);
    STAGE_T0(8);
    { int tid = tid0; asm volatile("" : "+v"(tid)); const int lane = tid & 63, wave = __builtin_amdgcn_readfirstlane(tid >> 6), q16 = lane & 15, g4 = lane >> 4; (void)lane; (void)wave; (void)q16; (void)g4;
    for (int ti = wave; ti < 16; ti += 8) {
        const int mt = ti >> 2, nt = ti & 3;
        f32x4 aL = (f32x4){0.f, 0.f, 0.f, 0.f}, aR = aL, aN = aL, aY = aL;
#pragma unroll
        for (int ks = 0; ks < 2; ++ks) { const int kb = ks * 64 + g4 * 16;
            const bf16x8 wt_n = ldfrag(lds + RL_WT, 16 * nt + q16, SA64, kb);
            aL = mfma16(wt_n, ldfrag(lds + RL_BHT, 16 * mt + q16, SA64, kb), aL);
            aR = mfma16(wt_n, ldfrag(lds + RL_ARB, 16 * mt + q16, SA64, kb), aR);
            const bf16x8 ut_m = ldfrag(lds + RL_UT, 16 * mt + q16, SA64, kb), vt_m = ldfrag(lds + RL_VT, 16 * mt + q16, SA64, kb);
            aN = mfma16(ldfrag(lds + RL_BHT, 16 * nt + q16, SA64, kb), ut_m, aN); aN = mfma16(ldfrag(lds + RL_KHT, 16 * nt + q16, SA64, kb), vt_m, aN);
            aY = mfma16(ldfrag(lds + RL_ARB, 16 * nt + q16, SA64, kb), ut_m, aY); aY = mfma16(ldfrag(lds + RL_ARK, 16 * nt + q16, SA64, kb), vt_m, aY);
        }
        const int row = 16 * mt + q16, col0 = 16 * nt + 4 * g4;
        const u32x2 rt = *(const LAS u32x2*)(lds + RL_RT + row * SA64 + col0 * 2);
        aR[0] += bflo(rt.x); aR[1] += bfhi(rt.x); aR[2] += bflo(rt.y); aR[3] += bfhi(rt.y);
        *(u32x2*)(uo + RU_L + ((mt * 2 + (nt >> 1)) * 64 + lane) * 16 + (nt & 1) * 8) = (u32x2){cvt_pk_bf16(aL[0], aL[1]), cvt_pk_bf16(aL[2], aL[3])};
        *(u32x2*)(uo + RU_RM + ((mt * 2 + (nt >> 1)) * 64 + lane) * 16 + (nt & 1) * 8) = (u32x2){cvt_pk_bf16(aR[0], aR[1]), cvt_pk_bf16(aR[2], aR[3])};
        *(u32x2*)(uo + RU_NT + ((mt * 64 + lane) * 4 + nt) * 8) = (u32x2){cvt_pk_bf16(aN[0], aN[1]), cvt_pk_bf16(aN[2], aN[3])};
        *(u32x2*)(uo + RU_YT + ((mt * 64 + lane) * 4 + nt) * 8) = (u32x2){cvt_pk_bf16(aY[0], aY[1]), cvt_pk_bf16(aY[2], aY[3])};
    }
    __syncthreads();
    }
    STAGE_T1(8);
}

DEV void rwkv_seqB(int bh, const unsigned char* iar, const float* gcr, const float* ln_w, const float* ln_b, bf16* mix, LAS unsigned char* lds, int tid) {
    const int lane = tid & 63, wave = __builtin_amdgcn_readfirstlane(tid >> 6), q16 = lane & 15, g4 = lane >> 4;
    const int h = bh & 7, b = bh >> 3, w = wave & 3, v = 16 * w + q16, chg = h * 64 + v;
    const bool act = wave < 4;
    const float lw = ln_w[chg], lb = ln_b[chg];
    LAS float* red = (LAS float*)(lds + 2 * RU_BYTES);
    f32x4 S[4];
#pragma unroll
    for (int i = 0; i < 4; ++i) S[i] = (f32x4){0.f, 0.f, 0.f, 0.f};
    blob_to_lds(iar + (size_t)(bh * NCH) * RU_BYTES, lds, RU_BYTES, wave, lane);
    f32x4 gcn[4];
#pragma unroll
    for (int kt = 0; kt < 4; ++kt) gcn[kt] = *(const f32x4*)(gcr + (size_t)(bh * NCH) * 64 + 16 * kt + 4 * g4);
    asm volatile("s_waitcnt vmcnt(0)" ::: "memory");
    __syncthreads();
    for (int c = 0; c < NCH; ++c) {
        const int unit = bh * NCH + c;
        const LAS unsigned char* bl = lds + (c & 1) * RU_BYTES;
        const size_t trow0 = (size_t)b * SEQ + (size_t)c * CH;
        f32x4 gc[4];
#pragma unroll
        for (int kt = 0; kt < 4; ++kt) gc[kt] = gcn[kt];
        if (c + 1 < NCH) { blob_to_lds(iar + (size_t)(unit + 1) * RU_BYTES, lds + ((c + 1) & 1) * RU_BYTES, RU_BYTES, wave, lane);
#pragma unroll
            for (int kt = 0; kt < 4; ++kt) gcn[kt] = *(const f32x4*)(gcr + (size_t)(unit + 1) * 64 + 16 * kt + 4 * g4); }
        f32x4 y[4];
        if (act) {
            bf16x8 sb[2];
#pragma unroll
            for (int ks = 0; ks < 2; ++ks) { const v4u t4 = (v4u){cvt_pk_bf16(S[2 * ks][0], S[2 * ks][1]), cvt_pk_bf16(S[2 * ks][2], S[2 * ks][3]), cvt_pk_bf16(S[2 * ks + 1][0], S[2 * ks + 1][1]), cvt_pk_bf16(S[2 * ks + 1][2], S[2 * ks + 1][3])};
                sb[ks] = __builtin_bit_cast(bf16x8, t4); }
            const LAS unsigned char* myc = bl + (w * 64 + lane) * 32;
#pragma unroll
            for (int mt = 0; mt < 4; ++mt) {
                const u32x2 yi = *(const LAS u32x2*)(myc + RU_YT + mt * 8);
                f32x4 acc = (f32x4){bflo(yi.x), bfhi(yi.x), bflo(yi.y), bfhi(yi.y)};
#pragma unroll
                for (int ks = 0; ks < 2; ++ks) acc = mfma16(*(const LAS bf16x8*)(bl + RU_RM + ((mt * 2 + ks) * 64 + lane) * 16), sb[ks], acc);
                y[mt] = acc;
            }
            f32x4 Sn[4];
#pragma unroll
            for (int kt = 0; kt < 4; ++kt) {
                const u32x2 ni = *(const LAS u32x2*)(myc + RU_NT + kt * 8);
                f32x4 acc = (f32x4){bflo(ni.x) + gc[kt][0] * S[kt][0], bfhi(ni.x) + gc[kt][1] * S[kt][1], bflo(ni.y) + gc[kt][2] * S[kt][2], bfhi(ni.y) + gc[kt][3] * S[kt][3]};
#pragma unroll
                for (int ks = 0; ks < 2; ++ks) acc = mfma16(*(const LAS bf16x8*)(bl + RU_L + ((kt * 2 + ks) * 64 + lane) * 16), sb[ks], acc);
                Sn[kt] = acc;
            }
#pragma unroll
            for (int kt = 0; kt < 4; ++kt) S[kt] = Sn[kt];
            LAS float* rw = red + (c & 1) * 512;
#pragma unroll
            for (int mt = 0; mt < 4; ++mt)
#pragma unroll
                for (int r = 0; r < 4; ++r) { float s1 = y[mt][r], s2 = s1 * s1;
                    s1 += __shfl_xor(s1, 1); s2 += __shfl_xor(s2, 1); s1 += __shfl_xor(s1, 2); s2 += __shfl_xor(s2, 2); s1 += __shfl_xor(s1, 4); s2 += __shfl_xor(s2, 4); s1 += __shfl_xor(s1, 8); s2 += __shfl_xor(s2, 8);
                    if (q16 == 0) { const int t = 16 * mt + 4 * g4 + r; rw[t * 8 + w * 2] = s1; rw[t * 8 + w * 2 + 1] = s2; } }
        }
        __syncthreads();
        if (act) {
            const LAS float* rr = red + (c & 1) * 512;
            const LAS unsigned char* myc = bl + (w * 64 + lane) * 32;
#pragma unroll
            for (int mt = 0; mt < 4; ++mt) {
                const u32x2 gi = *(const LAS u32x2*)(myc + RU_G + mt * 8), vi = *(const LAS u32x2*)(myc + RU_VB + mt * 8);
                const float gv[4] = {bflo(gi.x), bfhi(gi.x), bflo(gi.y), bfhi(gi.y)}, vb[4] = {bflo(vi.x), bfhi(vi.x), bflo(vi.y), bfhi(vi.y)};
#pragma unroll
                for (int r = 0; r < 4; ++r) { const int t = 16 * mt + 4 * g4 + r;
                    const LAS f32x4* rp = (const LAS f32x4*)(rr + t * 8); const f32x4 r0 = rp[0], r1 = rp[1];
                    const float mean = ((r0[0] + r0[2]) + (r1[0] + r1[2])) * (1.f / 64.f), ex2 = ((r0[1] + r0[3]) + (r1[1] + r1[3])) * (1.f / 64.f);
                    const float var = fmaxf(ex2 - mean * mean, 0.f);
                    mix[(trow0 + t) * D + chg] = (bf16)f2bf(((y[mt][r] - mean) * rsqrtf(var + GN_EPS) * lw + lb + vb[r]) * gv[r]); }
            }
        }
        asm volatile("s_waitcnt vmcnt(0)" ::: "memory");
        __syncthreads();
    }
}
DEV void ph_router(const float* h, const float* g2, const float* wrt2, const float* bg, const float* be, bf16* hn,
                   int* hist, int* tok_e, int* tok_pos, float* tok_gate, LAS float* lds_f, int blk, int G, int wave, int lane, unsigned long long& tacc) {
    const int q16 = lane & 15, g4 = lane >> 4, tw = wave & 3, kh = wave >> 2;
    LAS float* part = lds_f + tw * 1024;
    LAS float* lg = lds_f + 4096 + tw * 1024;
    LAS int* lcnt = (LAS int*)(lds_f + 8192);
    LAS float* lbias = lds_f + 8192 + 32;
    if (threadIdx.x < 32) lcnt[threadIdx.x] = 0;
    if (threadIdx.x < 36) lbias[threadIdx.x] = threadIdx.x < 32 ? be[threadIdx.x] : bg[threadIdx.x - 32];
    __syncthreads();
    f32x4 gg[4];
#pragma unroll
    for (int j = 0; j < 4; ++j) gg[j] = ((const f32x4*)g2)[lane + 64 * j];
    for (int tile = blk * 4 + tw; tile < T / 16; tile += G * 4) {
        const float* hrow = h + (size_t)(tile * 16 + q16) * D + 4 * g4 + kh * 512;
        const float* w0p = wrt2 + (size_t)q16 * D + 4 * g4 + kh * 512;
        f32x4 acc0 = (f32x4){0.f, 0.f, 0.f, 0.f}, acc1 = acc0, acc2 = acc0; float ssq = 0.f;
        f32x4 A0[4], B00[4], B01[4], B02[4], A1[4], B10[4], B11[4], B12[4];
#define RT_LOAD(Ax, Bx0, Bx1, Bx2, grp) _Pragma("unroll") for (int i = 0; i < 4; ++i) { const int k0 = (grp) * 64 + i * 16; Ax[i] = *(const f32x4*)(hrow + k0); Bx0[i] = *(const f32x4*)(w0p + k0); Bx1[i] = *(const f32x4*)(w0p + 16 * D + k0); Bx2[i] = *(const f32x4*)(w0p + 32 * D + k0); }
#define RT_COMP(Ax, Bx0, Bx1, Bx2) _Pragma("unroll") for (int i = 0; i < 4; ++i) { const f32x4 a = Ax[i]; ssq += (a[0] * a[0] + a[1] * a[1]) + (a[2] * a[2] + a[3] * a[3]); \
            _Pragma("unroll") for (int j = 0; j < 4; ++j) { acc0 = __builtin_amdgcn_mfma_f32_16x16x4f32(Bx0[i][j], a[j], acc0, 0, 0, 0); acc1 = __builtin_amdgcn_mfma_f32_16x16x4f32(Bx1[i][j], a[j], acc1, 0, 0, 0); acc2 = __builtin_amdgcn_mfma_f32_16x16x4f32(Bx2[i][j], a[j], acc2, 0, 0, 0); } }
        STAGE_T0(19);
        RT_LOAD(A0, B00, B01, B02, 0)
#pragma nounroll
        for (int gp = 0; gp < 8; gp += 2) {
            RT_LOAD(A1, B10, B11, B12, gp + 1)
            RT_COMP(A0, B00, B01, B02)
            if (gp + 2 < 8) { RT_LOAD(A0, B00, B01, B02, gp + 2) }
            RT_COMP(A1, B10, B11, B12)
        }
#undef RT_LOAD
#undef RT_COMP
        asm volatile("" : "+v"(acc0), "+v"(acc1), "+v"(acc2)); STAGE_T1(19);
        STAGE_T0(20);
        ssq += __shfl_xor(ssq, 16); ssq += __shfl_xor(ssq, 32);
        if (kh == 1) { *(LAS f32x4*)(part + q16 * 52 + 4 * g4) = acc0; *(LAS f32x4*)(part + q16 * 52 + 16 + 4 * g4) = acc1; *(LAS f32x4*)(part + q16 * 52 + 32 + 4 * g4) = acc2; if (g4 == 0) part[q16 * 52 + 48] = ssq; }
        __syncthreads();
        if (kh == 0) {
            acc0 += *(const LAS f32x4*)(part + q16 * 52 + 4 * g4); acc1 += *(const LAS f32x4*)(part + q16 * 52 + 16 + 4 * g4); acc2 += *(const LAS f32x4*)(part + q16 * 52 + 32 + 4 * g4); ssq += part[q16 * 52 + 48];
            const float rstd = rsqrtf(ssq * (1.f / D) + RMS_EPS);
            *(LAS f32x4*)(lg + q16 * 48 + 4 * g4) = acc0 * rstd; *(LAS f32x4*)(lg + q16 * 48 + 16 + 4 * g4) = acc1 * rstd; *(LAS f32x4*)(lg + q16 * 48 + 32 + 4 * g4) = acc2 * rstd;
            if (g4 == 0) part[q16 * 52 + 49] = rstd;
            asm volatile("s_waitcnt lgkmcnt(0)" ::: "memory");
            if (lane < 16) {
                const int t = tile * 16 + lane; const LAS float* L = lg + lane * 48;
                float gl[4]; float gm = -1e30f; int gi = 0;
#pragma unroll
                for (int g = 0; g < 4; ++g) { gl[g] = L[32 + g] + lbias[32 + g]; if (gl[g] > gm) { gm = gl[g]; gi = g; } }
                float gs = 0.f;
#pragma unroll
                for (int g = 0; g < 4; ++g) gs += __expf(gl[g] - gm);
                const float g_w = 1.f / gs;
                float el[8];
#pragma unroll
                for (int j = 0; j < 8; ++j) el[j] = L[gi * 8 + j] + lbias[gi * 8 + j];
                float m1 = -1e30f; int i1 = 0;
#pragma unroll
                for (int j = 0; j < 8; ++j) if (el[j] > m1) { m1 = el[j]; i1 = j; }
                float m2 = -1e30f; int i2 = 0;
#pragma unroll
                for (int j = 0; j < 8; ++j) if (j != i1 && el[j] > m2) { m2 = el[j]; i2 = j; }
                const float p2 = __expf(m2 - m1), w1 = 1.f / (1.f + p2), w2 = p2 / (1.f + p2);
                const int e1 = gi * 8 + i1, e2 = gi * 8 + i2;
                const int q1 = __hip_atomic_fetch_add(lcnt + e1, 1, __ATOMIC_RELAXED, __HIP_MEMORY_SCOPE_WORKGROUP), q2 = __hip_atomic_fetch_add(lcnt + e2, 1, __ATOMIC_RELAXED, __HIP_MEMORY_SCOPE_WORKGROUP);
                tok_e[2 * t] = e1; tok_e[2 * t + 1] = e2; tok_pos[2 * t] = (int)q1; tok_pos[2 * t + 1] = (int)q2; tok_gate[2 * t] = g_w * w1; tok_gate[2 * t + 1] = g_w * w2;
            }
        }
        __syncthreads();
        STAGE_T1(20);
        STAGE_T0(21);
#pragma unroll 4
        for (int r8 = 0; r8 < 8; ++r8) { const int r = kh * 8 + r8;
            const float rs = part[r * 52 + 49];
            const f32x4* xr = (const f32x4*)(h + (size_t)(tile * 16 + r) * D) + lane;
            unsigned long long* o8 = (unsigned long long*)(hn + (size_t)(tile * 16 + r) * D) + lane;
#pragma unroll
            for (int j = 0; j < 4; ++j) { const f32x4 v = xr[64 * j] * rs * gg[j]; o8[64 * j] = (unsigned long long)cvt_pk_bf16(v.x, v.y) | ((unsigned long long)cvt_pk_bf16(v.z, v.w) << 32); }
        }
        __syncthreads();
        STAGE_T1(21);
    }
    if (threadIdx.x < 32) hist[blk * 32 + threadIdx.x] = lcnt[threadIdx.x];
}
DEV void ph_scatter(const bf16* hn, const int* hist, const int* tok_e, const int* tok_pos, int* misc, bf16* xg, int* tok_slot, LAS int* lsm, int G, int gw, int NGW, int lane, int tid) {
    LAS int* pre = lsm;
    LAS int* offs = lsm + 256 * 32;
    LAS int* segs = offs + 32;
    __syncthreads();
    { const int e = tid & 31, sg = tid >> 5; int a = 0;
      const int per = (G + 15) >> 4;
      for (int i = 0; i < per; ++i) { const int b = sg * per + i; if (b < G) { const int v = hist[b * 32 + e]; pre[b * 32 + e] = a; a += v; } }
      segs[sg * 32 + e] = a; }
    __syncthreads();
    { const int e = tid & 31, sg = tid >> 5; int o = 0;
      for (int s2 = 0; s2 < sg; ++s2) o += segs[s2 * 32 + e];
      const int per = (G + 15) >> 4;
      for (int i = 0; i < per; ++i) { const int b = sg * per + i; if (b < G) pre[b * 32 + e] += o; } }
    __syncthreads();
    if (tid == 0) { int off = 0, nt = 0; const bool wr = blockIdx.x == 0;
        for (int e = 0; e < NE; ++e) { int c = 0; for (int s2 = 0; s2 < 16; ++s2) c += segs[s2 * 32 + e];
            const int tiles = (c + 255) >> 8; offs[e] = off;
            if (wr) for (int i = 0; i < tiles; ++i) misc[64 + nt + i] = e;
            nt += tiles; off += tiles * 256; }
        if (wr) misc[0] = nt; }
    __syncthreads();
    for (int t = gw; t < T; t += NGW) {
        const v4u* src = (const v4u*)(hn + (size_t)t * D) + lane;
        const v4u a = src[0], b = src[64];
        const int bsrc = (t >> 6) % G;
#pragma unroll
        for (int k = 0; k < 2; ++k) { const int e = tok_e[2 * t + k], slot = offs[e] + pre[bsrc * 32 + e] + tok_pos[2 * t + k];
            v4u* dst = (v4u*)(xg + (size_t)slot * D) + lane; dst[0] = a; dst[64] = b;
            if (lane == 0) tok_slot[2 * t + k] = slot; }
    }
}
DEV void ph_final(float* h, const bf16* yo, const int* tok_slot, const float* tok_gate, const float* gf, int gw, int NGW, int lane) {
    for (int t = gw; t < T; t += NGW) {
        f32x4* xr = (f32x4*)(h + (size_t)t * D) + lane; const f32x4* gr = (const f32x4*)gf + lane;
        const int s1 = tok_slot[2 * t], s2 = tok_slot[2 * t + 1]; const float g1 = tok_gate[2 * t], g2 = tok_gate[2 * t + 1];
        const unsigned long long* y1 = (const unsigned long long*)(yo + (size_t)s1 * D) + lane; const unsigned long long* y2 = (const unsigned long long*)(yo + (size_t)s2 * D) + lane;
        f32x4 v[4]; float s = 0.f;
#pragma unroll
        for (int j = 0; j < 4; ++j) { v[j] = xr[64 * j]; const unsigned long long a = y1[64 * j], b = y2[64 * j];
            v[j].x += g1 * bf2f((bf16)(a & 0xffff)) + g2 * bf2f((bf16)(b & 0xffff));
            v[j].y += g1 * bf2f((bf16)((a >> 16) & 0xffff)) + g2 * bf2f((bf16)((b >> 16) & 0xffff));
            v[j].z += g1 * bf2f((bf16)((a >> 32) & 0xffff)) + g2 * bf2f((bf16)((b >> 32) & 0xffff));
            v[j].w += g1 * bf2f((bf16)(a >> 48)) + g2 * bf2f((bf16)(b >> 48));
            s += (v[j].x * v[j].x + v[j].y * v[j].y) + (v[j].z * v[j].z + v[j].w * v[j].w); }
        const float rstd = rsqrtf(wave_sum(s) * (1.f / D) + RMS_EPS);
#pragma unroll
        for (int j = 0; j < 4; ++j) xr[64 * j] = v[j] * rstd * gr[64 * j];
    }
}

#ifndef MK_N_LAUNCHES
#define MK_N_LAUNCHES 1
#endif
constexpr int N_PHASES = 11;
struct Args { const float* in[27]; float* out; unsigned char* ws; int ph_lo, ph_hi; };
__global__ void __launch_bounds__(NTHR, 2) mega_kernel(Args args) {
    extern __shared__ __attribute__((aligned(16))) unsigned char lds_raw[];
    LAS unsigned char* lds = (LAS unsigned char*)lds_raw;
    volatile LAS unsigned* MISC = (volatile LAS unsigned*)(lds + MISC_OFF);
    const int tid = threadIdx.x, lane = tid & 63, wave = __builtin_amdgcn_readfirstlane(tid >> 6);
    const int G = gridDim.x, blk = blockIdx.x, gw = blk * NWAVES + wave, NGW = G * NWAVES;
    unsigned char* ws = args.ws; float* out = args.out; const float* const* in = args.in;
    bf16 *win_t = (bf16*)(ws + WS_WIN), *wout_t = (bf16*)(ws + WS_WOUT), *wgu_t = (bf16*)(ws + WS_WGU), *wd_t = (bf16*)(ws + WS_WD);
    bf16 *xn = (bf16*)(ws + WS_XN), *p = (bf16*)(ws + WS_P), *xg = (bf16*)(ws + WS_XG), *H = (bf16*)(ws + WS_H), *yo = (bf16*)(ws + WS_YO);
    float* wrt = (float*)(ws + WS_WRT); unsigned* ctl = (unsigned*)(ws + WS_CTL); int* misc = (int*)(ws + WS_MISC); int* hist = (int*)(ws + WS_MISC + 4096);
    int* tok_e = (int*)(ws + WS_TOK); int* tok_pos = tok_e + 2 * T; float* tok_gate = (float*)(tok_pos + 2 * T); int* tok_slot = (int*)(tok_gate + 2 * T);
    bf16* lora = (bf16*)(ws + WS_LORA); float* gcr = (float*)(ws + WS_GCR); float* dch = (float*)(ws + WS_DCH);
    for (int u = tid; u < (LDS_BYTES - LDSCTL_OFF) / 4; u += NTHR) ((LAS unsigned*)(lds + LDSCTL_OFF))[u] = 0u;
    __syncthreads();
    XcdBarrier bar; bar.bar = ctl + CW_BAR; bar.x = 0; bar.st = nullptr;
    const int lo = args.ph_lo, hi = args.ph_hi;
    if (hi - lo > 1) bar = xcd_barrier_post(ctl + CW_BAR, MISC + 8);
#define IN(k) (lo <= (k) && (k) < hi)
#define SEAM(k) do { if (IN(k) && IN((k) + 1)) xcd_barrier(bar); } while (0)
    LAS float* wscr = (LAS float*)(lds + wave * 16384);

#ifndef DUP_MASK
#define DUP_MASK 0
#endif
    unsigned long long tacc = 0;
#define PH0 do { ph_prep1(in[2], in[17], in[19], in[21], in[18], in[5], in[7], in[8], win_t, wout_t, wrt, lora, wscr, gw, NGW, lane); ph_rmsnorm(in[0], in[1], xn, gw, NGW, lane); } while (0)
#define PH1 do { pg8::Gemm g{D}; pg8::StaticOrder S; S.init(xn, win_t, T, DIN, D, G, blk); pg8::EpiBf16 E{p, DIN}; pg8::gemm_phase<pg8::EpiBf16, pg8::StaticOrder, true, true>(lds, g, S, E); } while (0)
#define PH2 do { for (int u = blk; u < BATCH * 8 * NCH; u += G) rwkv_unitA(u, p, in[3], in[4], in[6], in[9], in[10], in[11], lora, lora + 512 * 64, lora + 2 * 512 * 64, ws + WS_IAR, gcr, lds, tid, tacc); \
        { STAGE_T0(9); for (int u = blk; u < BATCH * 4 * NCH; u += G) hgrn_unitA(u, p, in[14], in[15], (unsigned char*)out, dch, xn, lds, tid); STAGE_T1(9); } } while (0)
#define PH3 do { if (blk < BATCH * 8) rwkv_seqB(blk, ws + WS_IAR, gcr, in[12], in[13], xn, lds, tid); \
        else if (blk < BATCH * 8 + BATCH * 4) hgrn_seqB(blk - BATCH * 8, (const unsigned char*)out, dch, in[16], xn, lds, tid); } while (0)
#define PH4 ph_prep2(in[23], in[24], in[25], wgu_t, wd_t, wscr, gw, NGW, lane)
#define PH5 do { pg8::Gemm g{D}; pg8::StaticOrder S; S.init(xn, wout_t, T, D, D, G, blk); pg8::EpiResF32 E{in[0], out, D}; pg8::gemm_phase<pg8::EpiResF32, pg8::StaticOrder, true, true>(lds, g, S, E); } while (0)
#define PH6 ph_router(out, in[18], wrt, in[20], in[22], xn, hist, tok_e, tok_pos, tok_gate, (LAS float*)lds, blk, G, wave, lane, tacc)
#define PH7 ph_scatter(xn, hist, tok_e, tok_pos, misc, xg, tok_slot, (LAS int*)lds, G, gw, NGW, lane, tid)
#define PH8 do { const int ntiles = __builtin_amdgcn_readfirstlane(misc[0]); pg8::Gemm g{D}; pg8::MoeOrder S; S.init(xg, wgu_t, misc + 64, ntiles, 1024, D, G, blk); pg8::EpiSwiGLU E{H, DE}; \
        pg8::gemm_phase<pg8::EpiSwiGLU, pg8::MoeOrder, true, true>(lds, g, S, E); } while (0)
#define PH9 do { const int ntiles = __builtin_amdgcn_readfirstlane(misc[0]); pg8::Gemm g{DE}; pg8::MoeOrder S; S.init(H, wd_t, misc + 64, ntiles, D, DE, G, blk); pg8::EpiBf16 E{yo, D}; \
        pg8::gemm_phase<pg8::EpiBf16, pg8::MoeOrder, true, true>(lds, g, S, E); } while (0)
#define PH10 ph_final(out, yo, tok_slot, tok_gate, in[26], gw, NGW, lane)
#define RUN(k, BODY) do { if (IN(k)) { BODY; if ((DUP_MASK >> (k)) & 1) { xcd_barrier(bar); BODY; } } } while (0)
    { STAGE_T0(13); RUN(0, PH0); STAGE_T1(13); } SEAM(0);
    { STAGE_T0(15); RUN(1, PH1); STAGE_T1(15); } SEAM(1);
    RUN(2, PH2);
    if (IN(2) && ((DUP_MASK >> 16) & 1)) { xcd_barrier(bar); for (int u = blk; u < BATCH * 8 * NCH; u += G) rwkv_unitA(u, p, in[3], in[4], in[6], in[9], in[10], in[11], lora, lora + 512 * 64, lora + 2 * 512 * 64, ws + WS_IAR, gcr, lds, tid, tacc); }
    if (IN(2) && ((DUP_MASK >> 17) & 1)) { xcd_barrier(bar); for (int u = blk; u < BATCH * 4 * NCH; u += G) hgrn_unitA(u, p, in[14], in[15], (unsigned char*)out, dch, xn, lds, tid); }
    SEAM(2);
    if (IN(3)) { PH3; if ((DUP_MASK >> 3) & 1) { xcd_barrier(bar); PH2; xcd_barrier(bar); PH3; } }
    SEAM(3);
    { STAGE_T0(14); RUN(4, PH4); STAGE_T1(14); } SEAM(4);
    { STAGE_T0(16); RUN(5, PH5); STAGE_T1(16); } SEAM(5);
    if (IN(6)) { STAGE_T0(10); PH6; STAGE_T1(10); }
    SEAM(6);
    if (IN(7)) { STAGE_T0(11); PH7; STAGE_T1(11); }
    SEAM(7);
    { STAGE_T0(17); RUN(8, PH8); STAGE_T1(17); } SEAM(8);
    { STAGE_T0(18); RUN(9, PH9); STAGE_T1(18); } SEAM(9);
    if (IN(10)) { STAGE_T0(12); PH10; STAGE_T1(12); }
    if (PROBE_STAGE != 0 && blk == 0) { const unsigned long long te = __builtin_amdgcn_s_memrealtime(); while (__builtin_amdgcn_s_memrealtime() - te < PROBE_AMP * tacc) __builtin_amdgcn_s_sleep(8); }
#undef IN
#undef SEAM
}

extern "C" void kernel_launch(void* const* d_in, const int* in_sizes, int n_in, void* d_out, int out_size, void* d_ws, size_t ws_size, hipStream_t stream) {
    static int grid = 0;
    if (grid == 0) {
        if (n_in != 27 || in_sizes[0] != T * D || out_size != T * D || ws_size < WS_END) { fprintf(stderr, "kernel_launch: unexpected shapes (n_in %d, in0 %d, out %d, ws %zu)\n", n_in, n_in > 0 ? in_sizes[0] : -1, out_size, ws_size); grid = -1; return; }
        int dev = 0, cus = 0;
        if (hipGetDevice(&dev) != hipSuccess || hipDeviceGetAttribute(&cus, hipDeviceAttributeMultiprocessorCount, dev) != hipSuccess) { grid = -1; return; }
        if (hipFuncSetAttribute((const void*)mega_kernel, hipFuncAttributeMaxDynamicSharedMemorySize, LDS_BYTES) != hipSuccess) { fprintf(stderr, "kernel_launch: hipFuncSetAttribute failed\n"); grid = -1; return; }
        grid = cus;
    }
    if (grid < 0) return;
    if (hipMemsetAsync((char*)d_ws + WS_CTL, 0, CTL_ZERO_BYTES, stream) != hipSuccess) return;
    Args a{};
    for (int i = 0; i < 27; ++i) a.in[i] = (const float*)d_in[i];
    a.out = (float*)d_out; a.ws = (unsigned char*)d_ws;
    if (MK_N_LAUNCHES == 1) { a.ph_lo = 0; a.ph_hi = N_PHASES; hipLaunchKernelGGL(mega_kernel, dim3(grid), dim3(NTHR), LDS_BYTES, stream, a); }
    else for (int k = 0; k < N_PHASES; ++k) { a.ph_lo = k; a.ph_hi = k + 1; hipLaunchKernelGGL(mega_kernel, dim3(grid), dim3(NTHR), LDS_BYTES, stream, a); }
}
```

```cpp
#include <hip/hip_runtime.h>
#include <cstdint>
#include <cstdio>

typedef unsigned short bf16;
#define DEV __device__ __forceinline__
DEV float bf2f(bf16 v) { return __uint_as_float(((unsigned)v) << 16); }
DEV unsigned f2bf(float f) { unsigned u = __float_as_uint(f); return (u + 0x7fffu + ((u >> 16) & 1u)) >> 16; }
DEV unsigned pk2(float lo, float hi) { return f2bf(lo) | (f2bf(hi) << 16); }
typedef float f32x2_t __attribute__((ext_vector_type(2)));
typedef __bf16 bf16x2_t __attribute__((ext_vector_type(2)));
DEV unsigned cvt_pk_bf16(float lo, float hi) { const f32x2_t v = {lo, hi}; return __builtin_bit_cast(unsigned, __builtin_convertvector(v, bf16x2_t)); }
DEV float wave_sum(float v) {
#pragma unroll
    for (int o = 1; o < 64; o <<= 1) v += __shfl_xor(v, o);
    return v;
}
template <int CTRL> DEV float dpp_mov(float x) { return __uint_as_float(__builtin_amdgcn_update_dpp(0u, __float_as_uint(x), CTRL, 0xf, 0xf, false)); }
DEV float row16_sum(float s) { s += dpp_mov<0x128>(s); s += dpp_mov<0x124>(s); s += dpp_mov<0x122>(s); s += dpp_mov<0x121>(s); return s; }
DEV float oct_sum(float s) { s += dpp_mov<0xB1>(s); s += dpp_mov<0x4E>(s); s += dpp_mov<0x141>(s); return s; }
DEV void lds_barrier() { asm volatile("s_waitcnt lgkmcnt(0)" ::: "memory"); __builtin_amdgcn_s_barrier(); asm volatile("" ::: "memory"); }
DEV float rdlane(float x, int k) { return __uint_as_float(__builtin_amdgcn_readlane(__float_as_uint(x), k)); }
DEV float sigmoidf_(float x) { return __builtin_amdgcn_rcpf(1.0f + __expf(-x)); }
DEV float tanhf_(float x) { return 1.0f - 2.0f * __builtin_amdgcn_rcpf(1.0f + __expf(2.0f * x)); }
DEV float bflo(unsigned w) { return __uint_as_float(w << 16); }
DEV float bfhi(unsigned w) { return __uint_as_float(w & 0xffff0000u); }

constexpr int BATCH = 8, SEQ = 2048, T = BATCH * SEQ, D = 1024;
constexpr int DR = 512, DH = 512, DRIN = 1792, DHIN = 2048, DIN = 3840;
constexpr int NE = 32, DE = 512;
constexpr float RMS_EPS = 1e-6f, GN_EPS = 64e-5f, L2_EPS = 1e-12f;
constexpr int MAXTILES = 160, MP = MAXTILES * 256;

constexpr size_t MiB = 1u << 20;
constexpr size_t WS_CTL = 0;
constexpr size_t WS_MISC = 64 * 1024;
constexpr size_t WS_WRT = 256 * 1024;
constexpr size_t WS_TOK = 512 * 1024;
constexpr size_t WS_WIN = 1 * MiB;
constexpr size_t WS_WOUT = 9 * MiB;
constexpr size_t WS_WGU = 139 * MiB;
constexpr size_t WS_WD = 203 * MiB;
constexpr size_t WS_XN = 107 * MiB;
constexpr size_t WS_P = 139 * MiB;
constexpr size_t WS_XG = 11 * MiB, WS_H = 91 * MiB, WS_YO = 11 * MiB;
constexpr size_t WS_END = 260 * MiB;
constexpr size_t WS_IAR = 11 * MiB;
constexpr size_t WS_GCR = 259 * MiB;
constexpr size_t WS_DCH = 259 * MiB + 512 * 1024;
constexpr size_t WS_LORA = 8 * MiB + 512 * 1024;

#ifndef PROBE_STAGE
#define PROBE_STAGE 0
#endif
#define PROBE_AMP 8
#ifndef PROBE_BLK
#define PROBE_BLK 0
#endif
#define STAGE_T0(k) unsigned long long t0_##k = 0; if (PROBE_STAGE == (k)) t0_##k = __builtin_amdgcn_s_memrealtime()
#define STAGE_T1(k) if (PROBE_STAGE == (k)) tacc += __builtin_amdgcn_s_memrealtime() - t0_##k
namespace pg8 {
#define PG8_LAS __attribute__((address_space(3)))
typedef unsigned short bf16_t;
typedef short bf16x8 __attribute__((ext_vector_type(8)));
typedef float f32x4 __attribute__((ext_vector_type(4)));
typedef unsigned u32x4 __attribute__((ext_vector_type(4)));
constexpr int BM = 256, BK = 64, HALF = 128, HTB = HALF * BK * 2  , STAGE_BYTES = 8 * HTB, NXCD = 8, WGM = 8;

__host__ __device__ __forceinline__ int lds_byte(int r, int c) { const int st = (r >> 4) * 2 + (c >> 5), rr = r & 15, cc = c & 31, ob = rr * 64 + cc * 2; return st * 1024 + (ob ^ (((ob >> 9) & 1) << 5)); }
__host__ __device__ __forceinline__ void stage_rc(int b, int& R, int& C) { const int st = b / 1024, sb = b % 1024, swz = sb ^ (((sb >> 9) & 1) << 5); R = (st >> 1) * 16 + swz / 64; C = (st & 1) * 32 + (swz % 64) / 2; }
__host__ __device__ __forceinline__ int perm32(int rho) { const int n = rho >> 4, i = rho & 15; return 8 * (i >> 2) + 4 * n + (i & 3); }

struct Unit { int pm, pn; const char* a; const char* b; };
struct Gemm { int K; };

__device__ __forceinline__ bool order_unit(long L, int nM, int nN, int& pm, int& pn) {
    const int nwg = nM * nN; if (L >= nwg) return false;
    int wgid = (int)L; { const int q = nwg / NXCD, r = nwg % NXCD, xcd = wgid % NXCD, off = wgid / NXCD; wgid = (xcd < r ? xcd * (q + 1) : r * (q + 1) + (xcd - r) * q) + off; }
    const int nig = WGM * nN, gid = wgid / nig, fm = gid * WGM, gsz = (nM - fm) < WGM ? (nM - fm) : WGM;
    pm = fm + ((wgid % nig) % gsz); pn = (wgid % nig) / gsz; return true;
}
struct StaticOrder {
    const char* A; const char* Bt; int nM, nN, G, c; size_t tstep;
    __device__ void init(const void* A_, const void* Bt_, int M, int N, int K, int G_, int c_) { A = (const char*)A_; Bt = (const char*)Bt_; nM = M / BM; nN = N / BM; G = G_; c = c_; tstep = (size_t)BM * K * 2; }
    __device__ bool next(int i, Unit& u) const {
        if (!order_unit((long)i * G + c, nM, nN, u.pm, u.pn)) return false;
        u.a = A + (size_t)u.pm * tstep; u.b = Bt + (size_t)u.pn * tstep; return true;
    }
    __device__ __forceinline__ void a_ready(const Unit&) const {}
    __device__ __forceinline__ void done(const Unit&) const {}
};
struct MoeOrder {
    const char* A; const char* Bt; const int* tile_expert; int nM, nN, G, c; size_t tstep, estep;
    __device__ void init(const void* A_, const void* Bt_, const int* te, int ntiles, int N, int K, int G_, int c_) { A = (const char*)A_; Bt = (const char*)Bt_; tile_expert = te; nM = ntiles; nN = N / BM; G = G_; c = c_; tstep = (size_t)BM * K * 2; estep = (size_t)N * K * 2; }
    __device__ bool next(int i, Unit& u) const {
        if (!order_unit((long)i * G + c, nM, nN, u.pm, u.pn)) return false;
        const int e = __builtin_amdgcn_readfirstlane(tile_expert[u.pm]);
        u.a = A + (size_t)u.pm * tstep; u.b = Bt + (size_t)e * estep + (size_t)u.pn * tstep; return true;
    }
    __device__ __forceinline__ void a_ready(const Unit&) const {}
    __device__ __forceinline__ void done(const Unit&) const {}
};

using ::cvt_pk_bf16;

struct EpiBf16 {
    static constexpr bool PERM = true, AFTER_DRAIN = false;
    bf16_t* O; int ldc;
    __device__ __forceinline__ void operator()(const f32x4 (&acc)[2][2][4][2], const Unit& u, int wr, int wc, int fr, int fq) const {
        const int row0 = u.pm * BM + wr * 64 + fr, col0 = u.pn * BM + wc * 32 + 8 * fq;
#pragma unroll
        for (int ai = 0; ai < 2; ++ai)
#pragma unroll
            for (int m = 0; m < 4; ++m) { bf16_t* rowp = O + (size_t)(row0 + ai * HALF + m * 16) * ldc + col0;
#pragma unroll
                for (int bj = 0; bj < 2; ++bj) { const f32x4 v0 = acc[ai][bj][m][0], v1 = acc[ai][bj][m][1];
                    u32x4 w; w.x = cvt_pk_bf16(v0[0], v0[1]); w.y = cvt_pk_bf16(v0[2], v0[3]); w.z = cvt_pk_bf16(v1[0], v1[1]); w.w = cvt_pk_bf16(v1[2], v1[3]);
                    *(u32x4*)(rowp + bj * HALF) = w; } }
    }
};
struct EpiResF32 {
    static constexpr bool PERM = false, AFTER_DRAIN = false;
    const float* base; float* C; int ldc;
    __device__ __forceinline__ void operator()(const f32x4 (&acc)[2][2][4][2], const Unit& u, int wr, int wc, int fr, int fq) const {
        const int row0 = u.pm * BM + wr * 64 + fr, col0 = u.pn * BM + wc * 32 + 4 * fq;
#pragma unroll
        for (int ai = 0; ai < 2; ++ai)
#pragma unroll
            for (int m = 0; m < 4; ++m) { const size_t off = (size_t)(row0 + ai * HALF + m * 16) * ldc + col0;
#pragma unroll
                for (int bj = 0; bj < 2; ++bj)
#pragma unroll
                    for (int n = 0; n < 2; ++n) *(f32x4*)(C + off + bj * HALF + n * 16) = *(const f32x4*)(base + off + bj * HALF + n * 16) + acc[ai][bj][m][n]; }
    }
};
struct EpiSwiGLU {
    static constexpr bool PERM = true, AFTER_DRAIN = false;
    bf16_t* H; int ldh;
    __device__ __forceinline__ void operator()(const f32x4 (&acc)[2][2][4][2], const Unit& u, int wr, int wc, int fr, int fq) const {
        const int row0 = u.pm * BM + wr * 64 + fr, col0 = u.pn * HALF + wc * 32 + 8 * fq;
#pragma unroll
        for (int ai = 0; ai < 2; ++ai)
#pragma unroll
            for (int m = 0; m < 4; ++m) { bf16_t* rowp = H + (size_t)(row0 + ai * HALF + m * 16) * ldh + col0;
                float o[8];
#pragma unroll
                for (int n = 0; n < 2; ++n)
#pragma unroll
                    for (int j = 0; j < 4; ++j) { const float g = acc[ai][0][m][n][j], up = acc[ai][1][m][n][j]; o[n * 4 + j] = g * up * __builtin_amdgcn_rcpf(1.0f + __expf(-g)); }
                u32x4 w; w.x = cvt_pk_bf16(o[0], o[1]); w.y = cvt_pk_bf16(o[2], o[3]); w.z = cvt_pk_bf16(o[4], o[5]); w.w = cvt_pk_bf16(o[6], o[7]);
                *(u32x4*)rowp = w; }
    }
};
template <class Epi, class Sched, bool ALIGN_EPI = false, bool SP2 = false>
__device__ __forceinline__ void gemm_phase(PG8_LAS unsigned char* lds, const Gemm g, const Sched& S, const Epi& E) {
    const int tid = threadIdx.x, wid = __builtin_amdgcn_readfirstlane(tid >> 6), lane = tid & 63, wr = wid >> 2, wc = wid & 3, fr = lane & 15, fq = lane >> 4;
    const int K = g.K, nt = K / BK;
    unsigned voffA[2], voffB[2];
#pragma unroll
    for (int i = 0; i < 2; ++i) { int R, C; stage_rc(tid * 16 + i * 8192, R, C); const int Rb = Epi::PERM ? ((R & ~31) + perm32(R & 31)) : R;
        voffA[i] = (unsigned)(R * K + C) * 2u; voffB[i] = (unsigned)(Rb * K + C) * 2u; }
    const size_t kstep = (size_t)(BK * 2);
    const size_t hstep = (size_t)HALF * K * 2;
    const unsigned ldsw = (unsigned)wid * 1024u;
    const int aoff = lds_byte(wr * 64 + fr, fq * 8), boff = lds_byte(wc * 32 + fr, fq * 8);
#define PG8_SA(b, h) (((b) * 2 + (h)) * HTB)
#define PG8_SB(b, h) ((4 + (b) * 2 + (h)) * HTB)
#define PG8_STAGE(bufoff, gbase, voff) do { _Pragma("unroll") for (int _i = 0; _i < 2; ++_i) \
        __builtin_amdgcn_global_load_lds((const unsigned*)((const char*)(gbase) + (voff)[_i]), (PG8_LAS unsigned*)(lds + (bufoff) + ldsw + _i * 8192), 16, 0, 0); } while (0)
#define PG8_LDA(dst, b, h) do { _Pragma("unroll") for (int m = 0; m < 4; ++m) _Pragma("unroll") for (int k = 0; k < 2; ++k) dst[m][k] = *(const PG8_LAS bf16x8*)(lds + PG8_SA(b, h) + aoff + m * 2048 + k * 1024); } while (0)
#define PG8_LDB(dst, b, h) do { _Pragma("unroll") for (int n = 0; n < 2; ++n) _Pragma("unroll") for (int k = 0; k < 2; ++k) dst[n][k] = *(const PG8_LAS bf16x8*)(lds + PG8_SB(b, h) + boff + n * 2048 + k * 1024); } while (0)
#define PG8_MMA(ai, bj, At, Bt) do { __builtin_amdgcn_s_setprio(1); _Pragma("unroll") for (int m = 0; m < 4; ++m) _Pragma("unroll") for (int n = 0; n < 2; ++n) _Pragma("unroll") for (int k = 0; k < 2; ++k) \
        acc[ai][bj][m][n] = __builtin_amdgcn_mfma_f32_16x16x32_bf16(Bt[n][k], At[m][k], acc[ai][bj][m][n], 0, 0, 0); __builtin_amdgcn_s_setprio(0); } while (0)
#define PG8_WAIT_V(n) asm volatile("s_waitcnt vmcnt(" #n ")" ::: "memory")
#define PG8_WAIT_L(n) asm volatile("s_waitcnt lgkmcnt(" #n ")" ::: "memory")
#define PG8_BAR __builtin_amdgcn_s_barrier()
#define PG8_SCHED __builtin_amdgcn_sched_barrier(0)
    Unit cur, nxt; int ui = 0;
    if (!S.next(0, cur)) return;
    f32x4 acc[2][2][4][2];
#pragma unroll
    for (int a = 0; a < 2; ++a)
#pragma unroll
        for (int b = 0; b < 2; ++b)
#pragma unroll
            for (int m = 0; m < 4; ++m)
#pragma unroll
                for (int n = 0; n < 2; ++n) acc[a][b][m][n] = (f32x4){0.f, 0.f, 0.f, 0.f};
    bf16x8 At[4][2], B0[2][2], B1[2][2];
    const char* cA = cur.a; const char* cB = cur.b;
    S.a_ready(cur);
    if constexpr (SP2) {
        PG8_STAGE(PG8_SB(0, 0), cB, voffB); PG8_STAGE(PG8_SB(0, 1), cB + hstep, voffB); PG8_STAGE(PG8_SA(0, 0), cA, voffA); PG8_STAGE(PG8_SA(0, 1), cA + hstep, voffA);
        if (wr == 1) PG8_BAR;
        PG8_WAIT_V(2); PG8_BAR;
        PG8_STAGE(PG8_SB(1, 0), cB + kstep, voffB); PG8_STAGE(PG8_SA(1, 0), cA + kstep, voffA); PG8_STAGE(PG8_SB(1, 1), cB + hstep + kstep, voffB);
        PG8_WAIT_V(6); PG8_BAR;
    } else {
        PG8_STAGE(PG8_SB(0, 0), cB, voffB); PG8_STAGE(PG8_SA(0, 0), cA, voffA); PG8_STAGE(PG8_SB(0, 1), cB + hstep, voffB); PG8_STAGE(PG8_SA(0, 1), cA + hstep, voffA);
        if (wr == 1) PG8_BAR;
        PG8_WAIT_V(4); PG8_BAR;
        PG8_STAGE(PG8_SB(1, 0), cB + kstep, voffB); PG8_STAGE(PG8_SA(1, 0), cA + kstep, voffA); PG8_STAGE(PG8_SB(1, 1), cB + hstep + kstep, voffB);
        PG8_WAIT_V(6); PG8_BAR;
    }
    for (;;) {
        const bool has_next = S.next(ui + 1, nxt);
        const char* nA = has_next ? nxt.a : cA; const char* nB = has_next ? nxt.b : cB;
        for (int t = 0; t < nt; t += 2) {
            const bool last = (t == nt - 2);
            const char* a1 = cA + (size_t)(t + 1) * kstep;
            const char* a2 = last ? nA : cA + (size_t)(t + 2) * kstep; const char* b2 = last ? nB : cB + (size_t)(t + 2) * kstep;
            const char* a3 = a2 + kstep; const char* b3 = b2 + kstep;
            if (last && has_next) S.a_ready(nxt);
            if constexpr (SP2) {
            PG8_LDB(B0, 0, 0); PG8_LDB(B1, 0, 1); PG8_SCHED; PG8_LDA(At, 0, 0); PG8_STAGE(PG8_SA(1, 1), a1 + hstep, voffA);
            PG8_WAIT_V(8); PG8_WAIT_L(0); PG8_BAR; PG8_MMA(0, 0, At, B0); PG8_MMA(0, 1, At, B1); PG8_BAR; PG8_SCHED;
            PG8_LDA(At, 0, 1); PG8_STAGE(PG8_SB(0, 0), b2, voffB); PG8_STAGE(PG8_SB(0, 1), b2 + hstep, voffB); PG8_STAGE(PG8_SA(0, 0), a2, voffA);
            PG8_WAIT_V(8); PG8_WAIT_L(0); PG8_BAR; PG8_MMA(1, 0, At, B0); PG8_MMA(1, 1, At, B1); PG8_BAR; PG8_SCHED;
            PG8_LDB(B0, 1, 0); PG8_LDB(B1, 1, 1); PG8_SCHED; PG8_LDA(At, 1, 0); PG8_STAGE(PG8_SA(0, 1), a2 + hstep, voffA);
            PG8_WAIT_V(8); PG8_WAIT_L(0); PG8_BAR; PG8_MMA(0, 0, At, B0); PG8_MMA(0, 1, At, B1); PG8_BAR; PG8_SCHED;
            PG8_LDA(At, 1, 1); PG8_STAGE(PG8_SB(1, 0), b3, voffB); PG8_STAGE(PG8_SB(1, 1), b3 + hstep, voffB); PG8_STAGE(PG8_SA(1, 0), a3, voffA);
            PG8_WAIT_V(8); PG8_WAIT_L(0); PG8_BAR; PG8_MMA(1, 0, At, B0); PG8_MMA(1, 1, At, B1); PG8_BAR; PG8_SCHED;
            } else {
            PG8_LDB(B0, 0, 0); PG8_SCHED; PG8_LDA(At, 0, 0); PG8_STAGE(PG8_SA(1, 1), a1 + hstep, voffA);
            PG8_WAIT_L(8); PG8_BAR; PG8_WAIT_L(0); PG8_MMA(0, 0, At, B0); PG8_BAR; PG8_SCHED;
            PG8_LDB(B1, 0, 1); PG8_STAGE(PG8_SB(0, 0), b2, voffB);
            PG8_BAR; PG8_WAIT_L(0); PG8_MMA(0, 1, At, B1); PG8_BAR;
            PG8_LDA(At, 0, 1); PG8_STAGE(PG8_SA(0, 0), a2, voffA);
            PG8_BAR; PG8_WAIT_L(0); PG8_MMA(1, 0, At, B0); PG8_BAR; PG8_SCHED;
            PG8_STAGE(PG8_SB(0, 1), b2 + hstep, voffB);
            PG8_WAIT_V(6); PG8_BAR; PG8_MMA(1, 1, At, B1); PG8_BAR;
            PG8_LDB(B0, 1, 0); PG8_SCHED; PG8_LDA(At, 1, 0); PG8_STAGE(PG8_SA(0, 1), a2 + hstep, voffA);
            PG8_WAIT_L(8); PG8_BAR; PG8_WAIT_L(0); PG8_MMA(0, 0, At, B0); PG8_BAR; PG8_SCHED;
            PG8_LDB(B1, 1, 1); PG8_STAGE(PG8_SB(1, 0), b3, voffB);
            PG8_BAR; PG8_WAIT_L(0); PG8_MMA(0, 1, At, B1); PG8_BAR;
            PG8_LDA(At, 1, 1); PG8_STAGE(PG8_SA(1, 0), a3, voffA);
            PG8_BAR; PG8_WAIT_L(0); PG8_MMA(1, 0, At, B0); PG8_BAR; PG8_SCHED;
            PG8_STAGE(PG8_SB(1, 1), b3 + hstep, voffB);
            PG8_WAIT_V(6); PG8_BAR; PG8_MMA(1, 1, At, B1); PG8_BAR;
            }
        }
        if constexpr (ALIGN_EPI) { if (wr == 0) PG8_BAR; }
        if constexpr (!Epi::AFTER_DRAIN) { E(acc, cur, wr, wc, fr, fq); S.done(cur); }
        if (!has_next) break;
#pragma unroll
        for (int a = 0; a < 2; ++a)
#pragma unroll
            for (int b = 0; b < 2; ++b)
#pragma unroll
                for (int m = 0; m < 4; ++m)
#pragma unroll
                    for (int n = 0; n < 2; ++n) acc[a][b][m][n] = (f32x4){0.f, 0.f, 0.f, 0.f};
        cur = nxt; cA = nA; cB = nB; ++ui;
        if constexpr (ALIGN_EPI) { if (wr == 1) PG8_BAR; }
    }
    PG8_WAIT_V(0);
    if constexpr (!ALIGN_EPI) { if (wr == 0) PG8_BAR; }
    PG8_BAR;
    if constexpr (Epi::AFTER_DRAIN) { E.fused(acc, cur, wr, wc, fr, fq, lds, wid, lane); S.done(cur); }
#undef PG8_SA
#undef PG8_SB
#undef PG8_STAGE
#undef PG8_LDA
#undef PG8_LDB
#undef PG8_MMA
#undef PG8_WAIT_V
#undef PG8_WAIT_L
#undef PG8_BAR
#undef PG8_SCHED
}
}
#define LAS __attribute__((address_space(3)))
#define GAS __attribute__((address_space(1)))
typedef unsigned v4u __attribute__((ext_vector_type(4)));
typedef float f32x4 __attribute__((ext_vector_type(4)));
constexpr int NWAVES = 8, NTHR = 512;
constexpr int LDS_BYTES = 163840;
constexpr int LDSCTL_OFF = LDS_BYTES - 1024, MISC_OFF = LDSCTL_OFF + 320;
constexpr int CW_CNT = 0;
constexpr int CW_BAR = 1024;
constexpr size_t CTL_ZERO_BYTES = 64 * 1024;

#define XB_TMO      128
#define XB_XCNT(j)  (256  + 64 * (j))
#define XB_XSUB(j)  (1280 + 64 * (j))
#define XB_XGEN(j)  (2304 + 64 * (j))
#define XB_TOP      3328
#define XB_TOPGEN   3392
#define XCD_BAR_WORDS 3456
#define XB_SPIN_CAP (1u << 18)
DEV unsigned xb_ld(unsigned* p)              { return __hip_atomic_load(p, __ATOMIC_RELAXED, __HIP_MEMORY_SCOPE_AGENT); }
DEV unsigned xb_add(unsigned* p, unsigned v) { return __hip_atomic_fetch_add(p, v, __ATOMIC_RELAXED, __HIP_MEMORY_SCOPE_AGENT); }
DEV unsigned xb_xcc_id() { return (unsigned)__builtin_amdgcn_s_getreg((3 << 11) | 20) & 0xFu; }
#define XB_SPIN(cond, bar) do { unsigned _sp = 0; while (cond) { __builtin_amdgcn_s_sleep(1); \
    if ((++_sp & 255u) == 0u) { if (xb_ld(&(bar)[XB_TMO])) break; if (_sp > XB_SPIN_CAP) { atomicAdd(&(bar)[XB_TMO], 1u); break; } } } } while (0)
struct XcdBarrier { unsigned* bar; unsigned x; volatile LAS unsigned* st; };
DEV XcdBarrier xcd_barrier_post(unsigned* bar, volatile LAS unsigned* st) {
    XcdBarrier b; b.bar = bar; b.x = xb_xcc_id(); b.st = st;
    if (threadIdx.x == 0) (void)xb_add(&bar[XB_XCNT(b.x)], 1u);
    return b;
}
DEV void xcd_barrier_complete(unsigned* bar, unsigned x, unsigned& nloc, unsigned& nx) {
    const unsigned G = gridDim.x * gridDim.y * gridDim.z;
    unsigned sum, cnt, mine, sp = 0u;
    for (;;) {
        sum = 0u; cnt = 0u; mine = 0u;
#pragma unroll
        for (unsigned j = 0; j < 16; ++j) { const unsigned c = xb_ld(&bar[XB_XCNT(j)]); sum += c; cnt += (c > 0u) ? 1u : 0u; mine = (j == x) ? c : mine; }
        if (sum == G) break;
        __builtin_amdgcn_s_sleep(1);
        if ((++sp & 255u) == 0u) { if (xb_ld(&bar[XB_TMO])) break; if (sp > XB_SPIN_CAP) { atomicAdd(&bar[XB_TMO], 1u); break; } }
    }
    nloc = mine > 0u ? mine : 1u; nx = cnt > 0u ? cnt : 1u;
}
DEV void xcd_barrier(const XcdBarrier& b) {
    asm volatile("s_waitcnt vmcnt(0)" ::: "memory");
    __syncthreads();
    if (threadIdx.x == 0) {
        unsigned* bar = b.bar;
        __builtin_amdgcn_s_waitcnt(0);
        unsigned nloc = b.st[0], nx = b.st[1];
        if (nloc == 0u) { xcd_barrier_complete(bar, b.x, nloc, nx); b.st[0] = nloc; b.st[1] = nx; }
        const unsigned old = xb_add(&bar[XB_XSUB(b.x)], 1u);
        const unsigned gen = old / nloc;
        if (old + 1u == (gen + 1u) * nloc) {
            __builtin_amdgcn_fence(__ATOMIC_RELEASE, "agent");
            asm volatile("s_waitcnt vmcnt(0)" ::: "memory");
            const unsigned og = xb_add(&bar[XB_TOP], 1u);
            const unsigned tg = og / nx;
            if (og + 1u == (tg + 1u) * nx) xb_add(&bar[XB_TOPGEN], 1u);
            else XB_SPIN(xb_ld(&bar[XB_TOPGEN]) == tg, bar);
            __builtin_amdgcn_fence(__ATOMIC_ACQUIRE, "agent");
            xb_add(&bar[XB_XGEN(b.x)], 1u);
            asm volatile("s_waitcnt vmcnt(0)" ::: "memory");
        } else {
            XB_SPIN(xb_ld(&bar[XB_XGEN(b.x)]) == gen, bar);
            __builtin_amdgcn_fence(__ATOMIC_ACQUIRE, "agent");
            asm volatile("s_waitcnt vmcnt(0)" ::: "memory");
        }
    }
    __syncthreads();
}

DEV void transpose_item(const float* W, int N, int k0, int n0, bf16* dst, int ldk, LAS float* scr, int lane) {
#pragma unroll 8
    for (int i = 0; i < 32; ++i) { const int kk = 2 * i + (lane >> 5); scr[kk * 33 + (lane & 31)] = W[(size_t)(k0 + kk) * N + n0 + (lane & 31)]; }
    asm volatile("s_waitcnt lgkmcnt(0)" ::: "memory");
    const int c = lane & 7;
#pragma unroll
    for (int j = 0; j < 4; ++j) { const int n = (lane >> 3) + 8 * j; const LAS float* s = scr + (8 * c) * 33 + n;
        v4u o; o.x = pk2(s[0 * 33], s[1 * 33]); o.y = pk2(s[2 * 33], s[3 * 33]); o.z = pk2(s[4 * 33], s[5 * 33]); o.w = pk2(s[6 * 33], s[7 * 33]);
        *(v4u*)(dst + (size_t)n * ldk + k0 + 8 * c) = o; }
    asm volatile("s_waitcnt lgkmcnt(0)" ::: "memory");
}
DEV void ph_prep1(const float* w_in, const float* w_out, const float* rgw, const float* rew, const float* g2, const float* w_up, const float* a_up, const float* g_up, bf16* win_t, bf16* wout_t, float* wrt, bf16* lora, LAS float* scr, int gw, int NGW, int lane) {
    for (int i = gw * 64 + lane; i < 512 * 256; i += NGW * 64) { const int c = i >> 8, j = i & 255;
        if (j < 64) lora[c * 64 + j] = (bf16)f2bf(w_up[j * DR + c]); else if (j < 128) lora[512 * 64 + c * 64 + (j - 64)] = (bf16)f2bf(a_up[(j - 64) * DR + c]); else lora[2 * 512 * 64 + c * 128 + (j - 128)] = (bf16)f2bf(g_up[(j - 128) * DR + c]); }
    constexpr int I_IN = (D / 64) * (DIN / 32), I_OUT = (D / 64) * (D / 32);
    for (int it = gw; it < I_IN + I_OUT; it += NGW) {
        if (it < I_IN) { const int nblk = DIN / 32, kb = it / nblk, nb = it % nblk; transpose_item(w_in, DIN, 64 * kb, 32 * nb, win_t + (size_t)(32 * nb) * D, D, scr, lane); }
        else { const int r = it - I_IN, nblk = D / 32, kb = r / nblk, nb = r % nblk; transpose_item(w_out, D, 64 * kb, 32 * nb, wout_t + (size_t)(32 * nb) * D, D, scr, lane); }
    }
    for (int i = gw * 64 + lane; i < 48 * 1024; i += NGW * 64) { const int e = i >> 10, d = i & 1023; wrt[i] = e < 32 ? rew[d * 32 + e] * g2[d] : (e < 36 ? rgw[d * 4 + (e - 32)] * g2[d] : 0.f); }
}
DEV void ph_prep2(const float* wg, const float* wu, const float* wd, bf16* wgu_t, bf16* wd_t, LAS float* scr, int gw, int NGW, int lane) {
    constexpr int I_G = (D / 64) * (DE / 32), I_D = (DE / 64) * (D / 32), PER_E = 2 * I_G + I_D;
    for (int it = gw; it < NE * PER_E; it += NGW) {
        const int e = it / PER_E; int r = it % PER_E;
        if (r < 2 * I_G) { const int up = r >= I_G; if (up) r -= I_G; const int nblk = DE / 32, kb = r / nblk, nb = r % nblk, n0 = 32 * nb;
            const float* W = (up ? wu : wg) + (size_t)e * D * DE;
            bf16* dst = wgu_t + ((size_t)e * 1024 + (n0 >> 7) * 256 + up * 128 + (n0 & 127)) * D;
            transpose_item(W, DE, 64 * kb, n0, dst, D, scr, lane); }
        else { r -= 2 * I_G; const int nblk = D / 32, kb = r / nblk, nb = r % nblk, n0 = 32 * nb;
            transpose_item(wd + (size_t)e * DE * D, D, 64 * kb, n0, wd_t + ((size_t)e * D + n0) * DE, DE, scr, lane); }
    }
}
DEV void ph_rmsnorm(const float* x, const float* g, bf16* out, int gw, int NGW, int lane) {
    for (int row = gw; row < T; row += NGW) {
        const f32x4* xr = (const f32x4*)(x + (size_t)row * D) + lane; const f32x4* gr = (const f32x4*)g + lane;
        f32x4 v[4]; float s = 0.f;
#pragma unroll
        for (int j = 0; j < 4; ++j) { v[j] = xr[64 * j]; s += (v[j].x * v[j].x + v[j].y * v[j].y) + (v[j].z * v[j].z + v[j].w * v[j].w); }
        const float rstd = rsqrtf(wave_sum(s) * (1.f / D) + RMS_EPS);
        unsigned long long* o8 = (unsigned long long*)(out + (size_t)row * D) + lane;
#pragma unroll
        for (int j = 0; j < 4; ++j) { const f32x4 gg = gr[64 * j]; o8[64 * j] = (unsigned long long)pk2(v[j].x * rstd * gg.x, v[j].y * rstd * gg.y) | ((unsigned long long)pk2(v[j].z * rstd * gg.z, v[j].w * rstd * gg.w) << 32); }
    }
}

typedef short bf16x8 __attribute__((ext_vector_type(8)));
typedef short bf16x4 __attribute__((ext_vector_type(4)));
typedef unsigned u32x2 __attribute__((ext_vector_type(2)));
DEV f32x4 mfma16(bf16x8 f, bf16x8 g, f32x4 c) { return __builtin_amdgcn_mfma_f32_16x16x32_bf16(f, g, c, 0, 0, 0); }
DEV unsigned cvtpk(float lo, float hi) { return cvt_pk_bf16(lo, hi); }
DEV bf16x8 ldfrag(const LAS unsigned char* base, int row, int stride, int kbyte) { return *(const LAS bf16x8*)(base + row * stride + kbyte); }
constexpr int SA64 = 144, SA128 = 272;
constexpr int CH = 64, NCH = SEQ / CH;

constexpr int HU_QH = 0, HU_OT = 16384, HU_UT = 32768, HU_BYTES = 65536;
constexpr int HL_QT = 0, HL_KT = 17408, HL_KHT = 34816, HL_VT = 53248, HL_SC = 71680, HL_PFX = 80896;
DEV void hgrn_unitA(int unit, const bf16* p, const float* cw, const float* lbl, unsigned char* iah, float* dch, bf16* mix, LAS unsigned char* lds, int tid) {
    const int c = unit & 31, h = (unit >> 5) & 3, b = unit >> 7;
    const int lane = tid & 63, wave = tid >> 6, q16 = lane & 15, g4 = lane >> 4;
    const size_t trow0 = (size_t)b * SEQ + (size_t)c * CH;
    unsigned char* uo = iah + (size_t)unit * HU_BYTES;
    LAS float* pfx = (LAS float*)(lds + HL_PFX);
    const int cc = tid & 15, run = tid >> 4, c0 = 8 * cc, tl = 2 * run;
    float qv[2][8], lfv[2][8], khv[2][8];
    {
        v4u rq[5], rf[5];
#pragma unroll
        for (int i = 0; i < 5; ++i) { const int sl = c * CH + tl - 3 + i;
            if (sl >= 0) { const bf16* row = p + (trow0 + tl - 3 + i) * DIN + DRIN + h * 128 + c0; rq[i] = *(const v4u*)row; rf[i] = *(const v4u*)(row + 512); }
            else { rq[i] = (v4u){0u, 0u, 0u, 0u}; rf[i] = (v4u){0u, 0u, 0u, 0u}; } }
#pragma unroll
        for (int e = 0; e < 8; ++e) {
            const int col = h * 128 + c0 + e;
            float wq[4], wf[4];
#pragma unroll
            for (int j = 0; j < 4; ++j) { wq[j] = cw[j * 1536 + col]; wf[j] = cw[j * 1536 + 512 + col]; }
            const float lb = __builtin_amdgcn_rcpf(1.f + __expf(lbl[512 + col] - lbl[col]));
            float xq[5], xf[5];
#pragma unroll
            for (int i = 0; i < 5; ++i) { const unsigned wq_ = rq[i][e >> 1], wf_ = rf[i][e >> 1];
                xq[i] = (e & 1) ? __uint_as_float(wq_ & 0xffff0000u) : __uint_as_float(wq_ << 16);
                xf[i] = (e & 1) ? __uint_as_float(wf_ & 0xffff0000u) : __uint_as_float(wf_ << 16); }
#pragma unroll
            for (int tt = 0; tt < 2; ++tt) {
                const float aq = wq[0] * xq[tt] + wq[1] * xq[tt + 1] + wq[2] * xq[tt + 2] + wq[3] * xq[tt + 3];
                const float af = wf[0] * xf[tt] + wf[1] * xf[tt + 1] + wf[2] * xf[tt + 2] + wf[3] * xf[tt + 3];
                const float fg = lb + (1.f - lb) * sigmoidf_(af);
                qv[tt][e] = aq * sigmoidf_(aq); lfv[tt][e] = __logf(fg); khv[tt][e] = 1.f - fg; }
            pfx[run * 128 + c0 + e] = lfv[0][e] + lfv[1][e];
        }
    }
    lds_barrier();
    if (tid < 128) { float a = 0.f;
#pragma unroll 8
        for (int r = 0; r < 32; ++r) { const float v = pfx[r * 128 + tid]; pfx[r * 128 + tid] = a; a += v; }
        pfx[32 * 128 + tid] = a; }
    lds_barrier();
    {
        unsigned qt[2][4], kt[2][4], qh[2][4];
#pragma unroll
        for (int e = 0; e < 8; ++e) {
            const int k = c0 + e;
            const float base = pfx[run * 128 + k], ref = pfx[16 * 128 + k], tot = pfx[32 * 128 + k];
            const float eref = __expf(ref), etr = __expf(tot - ref);
            float val_qt[2], val_kt[2], val_qh[2], val_kh[2];
            float bc = base;
#pragma unroll
            for (int tt = 0; tt < 2; ++tt) { bc += lfv[tt][e]; const float E = __expf(bc - ref), Ei = __builtin_amdgcn_rcpf(E);
                val_qt[tt] = qv[tt][e] * E; val_kt[tt] = khv[tt][e] * Ei; val_qh[tt] = val_qt[tt] * eref; val_kh[tt] = val_kt[tt] * etr; }
            *(LAS unsigned*)(lds + HL_KHT + k * SA64 + tl * 2) = cvtpk(val_kh[0], val_kh[1]);
            if (e & 1) {
#pragma unroll
                for (int tt = 0; tt < 2; ++tt) { qt[tt][e >> 1] = (qt[tt][e >> 1] & 0xffffu) | (f2bf(val_qt[tt]) << 16); kt[tt][e >> 1] = (kt[tt][e >> 1] & 0xffffu) | (f2bf(val_kt[tt]) << 16); qh[tt][e >> 1] = (qh[tt][e >> 1] & 0xffffu) | (f2bf(val_qh[tt]) << 16); }
            } else {
#pragma unroll
                for (int tt = 0; tt < 2; ++tt) { qt[tt][e >> 1] = f2bf(val_qt[tt]); kt[tt][e >> 1] = f2bf(val_kt[tt]); qh[tt][e >> 1] = f2bf(val_qh[tt]); }
            }
            if (run == 0) dch[(size_t)unit * 128 + k] = __expf(tot);
        }
#pragma unroll
        for (int tt = 0; tt < 2; ++tt) {
            *(LAS v4u*)(lds + HL_QT + (tl + tt) * SA128 + c0 * 2) = (v4u){qt[tt][0], qt[tt][1], qt[tt][2], qt[tt][3]};
            *(LAS v4u*)(lds + HL_KT + (tl + tt) * SA128 + c0 * 2) = (v4u){kt[tt][0], kt[tt][1], kt[tt][2], kt[tt][3]};
            { const int t = tl + tt, o32 = c0 & 31, ksq = c0 >> 5, half = o32 >> 4, gq = (o32 & 15) >> 2;
              unsigned char* qb = uo + HU_QH + (((t >> 4) * 4 + ksq) * 64 + (t & 15)) * 16 + half * 8;
              *(u32x2*)(qb + gq * 256) = (u32x2){qh[tt][0], qh[tt][1]}; *(u32x2*)(qb + (gq + 1) * 256) = (u32x2){qh[tt][2], qh[tt][3]}; }
        }
    }
    {
        v4u ri[5];
#pragma unroll
        for (int i = 0; i < 5; ++i) { const int sl = c * CH + tl - 3 + i;
            if (sl >= 0) ri[i] = *(const v4u*)(p + (trow0 + tl - 3 + i) * DIN + DRIN + 1024 + h * 128 + c0); else ri[i] = (v4u){0u, 0u, 0u, 0u}; }
#pragma unroll
        for (int e = 0; e < 8; ++e) {
            const int col = h * 128 + c0 + e;
            float wi[4], xi[5];
#pragma unroll
            for (int j = 0; j < 4; ++j) wi[j] = cw[j * 1536 + 1024 + col];
#pragma unroll
            for (int i = 0; i < 5; ++i) { const unsigned w_ = ri[i][e >> 1]; xi[i] = (e & 1) ? __uint_as_float(w_ & 0xffff0000u) : __uint_as_float(w_ << 16); }
            const float v0 = wi[0] * xi[0] + wi[1] * xi[1] + wi[2] * xi[2] + wi[3] * xi[3], v1 = wi[0] * xi[1] + wi[1] * xi[2] + wi[2] * xi[3] + wi[3] * xi[4];
            *(LAS unsigned*)(lds + HL_VT + (c0 + e) * SA64 + tl * 2) = cvtpk(v0, v1);
        }
#pragma unroll
        for (int tt = 0; tt < 2; ++tt) { const v4u gr = *(const v4u*)(p + (trow0 + tl + tt) * DIN + DRIN + 1536 + h * 128 + c0); unsigned o[4];
#pragma unroll
            for (int e2 = 0; e2 < 4; ++e2) { const float g0 = __uint_as_float(gr[e2] << 16), g1 = __uint_as_float(gr[e2] & 0xffff0000u); o[e2] = cvtpk(g0 * sigmoidf_(g0), g1 * sigmoidf_(g1)); }
            *(v4u*)(mix + (trow0 + tl + tt) * D + 512 + h * 128 + c0) = (v4u){o[0], o[1], o[2], o[3]}; }
    }
    lds_barrier();
    for (int ti = wave; ti < 16; ti += 8) {
        const int mt = ti >> 2, nt = ti & 3;
        f32x4 acc = (f32x4){0.f, 0.f, 0.f, 0.f};
        if (nt <= mt) {
#pragma unroll
            for (int ks = 0; ks < 4; ++ks) acc = mfma16(ldfrag(lds + HL_KT, 16 * nt + q16, SA128, ks * 64 + g4 * 16), ldfrag(lds + HL_QT, 16 * mt + q16, SA128, ks * 64 + g4 * 16), acc);
            if (nt == mt) {
#pragma unroll
                for (int r = 0; r < 4; ++r) if (4 * g4 + r > q16) acc[r] = 0.f; }
        }
        *(LAS u32x2*)(lds + HL_SC + (16 * mt + q16) * SA64 + (16 * nt + 4 * g4) * 2) = (u32x2){cvtpk(acc[0], acc[1]), cvtpk(acc[2], acc[3])};
    }
    lds_barrier();
    {
        const int vrow = 16 * wave + q16;
        const bf16x8 vf0 = ldfrag(lds + HL_VT, vrow, SA64, g4 * 16), vf1 = ldfrag(lds + HL_VT, vrow, SA64, 64 + g4 * 16);
#pragma unroll
        for (int mt = 0; mt < 4; ++mt) {
            f32x4 acc = (f32x4){0.f, 0.f, 0.f, 0.f};
            acc = mfma16(ldfrag(lds + HL_SC, 16 * mt + q16, SA64, g4 * 16), vf0, acc);
            acc = mfma16(ldfrag(lds + HL_SC, 16 * mt + q16, SA64, 64 + g4 * 16), vf1, acc);
            *(u32x2*)(uo + HU_OT + ((wave * 64 + lane) * 4 + mt) * 8) = (u32x2){cvtpk(acc[0], acc[1]), cvtpk(acc[2], acc[3])};
        }
#pragma unroll
        for (int kt = 0; kt < 8; ++kt) {
            f32x4 acc = (f32x4){0.f, 0.f, 0.f, 0.f};
            acc = mfma16(ldfrag(lds + HL_KHT, 16 * kt + q16, SA64, g4 * 16), vf0, acc);
            acc = mfma16(ldfrag(lds + HL_KHT, 16 * kt + q16, SA64, 64 + g4 * 16), vf1, acc);
            *(u32x2*)(uo + HU_UT + ((wave * 64 + lane) * 8 + kt) * 8) = (u32x2){cvtpk(acc[0], acc[1]), cvtpk(acc[2], acc[3])};
        }
    }
    lds_barrier();
}

DEV void blob_to_lds(const unsigned char* src, LAS unsigned char* dst, int bytes, int wave, int lane) {
    for (int j = wave; j < bytes / 1024; j += NWAVES) __builtin_amdgcn_global_load_lds((const unsigned*)(src + j * 1024 + lane * 16), (LAS unsigned*)(dst + j * 1024), 16, 0, 0);
}
DEV void hgrn_seqB(int bh, const unsigned char* iah, const float* dch, const float* ng, bf16* mix, LAS unsigned char* lds, int tid, unsigned long long& tacc) {
    const int lane = tid & 63, wave = __builtin_amdgcn_readfirstlane(tid >> 6), q16 = lane & 15, g4 = lane >> 4;
    const int h = bh & 3, b = bh >> 2, v = 16 * wave + q16;
    const float gain = ng[h * 128 + v];
    LAS float* dls = (LAS float*)(lds + 2 * HU_BYTES); LAS float* red = dls + 256;
    f32x4 S[8];
#pragma unroll
    for (int i = 0; i < 8; ++i) S[i] = (f32x4){0.f, 0.f, 0.f, 0.f};
    blob_to_lds(iah + (size_t)(bh * NCH) * HU_BYTES, lds, HU_BYTES, wave, lane);
    if (tid < 128) dls[tid] = dch[(size_t)(bh * NCH) * 128 + tid];
    asm volatile("s_waitcnt vmcnt(0)" ::: "memory");
    lds_barrier();
    for (int c = 0; c < NCH; ++c) {
        STAGE_T0(23);
        const LAS unsigned char* bl = lds + (c & 1) * HU_BYTES;
        const size_t trow0 = (size_t)b * SEQ + (size_t)c * CH;
        float dnext = 0.f;
        if (c + 1 < NCH) { blob_to_lds(iah + (size_t)(bh * NCH + c + 1) * HU_BYTES, lds + ((c + 1) & 1) * HU_BYTES, HU_BYTES, wave, lane);
            if (tid < 128) dnext = dch[(size_t)(bh * NCH + c + 1) * 128 + tid]; }
        float gate[4][4];
#pragma unroll
        for (int mt = 0; mt < 4; ++mt)
#pragma unroll
            for (int r = 0; r < 4; ++r) gate[mt][r] = bf2f(mix[(trow0 + 16 * mt + 4 * g4 + r) * D + 512 + h * 128 + v]);
        bf16x8 sb[4];
#pragma unroll
        for (int ks = 0; ks < 4; ++ks) { const v4u t4 = (v4u){cvt_pk_bf16(S[2 * ks][0], S[2 * ks][1]), cvt_pk_bf16(S[2 * ks][2], S[2 * ks][3]), cvt_pk_bf16(S[2 * ks + 1][0], S[2 * ks + 1][1]), cvt_pk_bf16(S[2 * ks + 1][2], S[2 * ks + 1][3])};
            sb[ks] = __builtin_bit_cast(bf16x8, t4); }
        f32x4 o[4];
        const LAS unsigned char* myo = bl + HU_OT + (wave * 64 + lane) * 32, *myu = bl + HU_UT + (wave * 64 + lane) * 64;
#pragma unroll
        for (int mt = 0; mt < 4; ++mt) {
            const u32x2 oi = *(const LAS u32x2*)(myo + mt * 8);
            f32x4 acc = (f32x4){bflo(oi.x), bfhi(oi.x), bflo(oi.y), bfhi(oi.y)};
#pragma unroll
            for (int ks = 0; ks < 4; ++ks) acc = mfma16(*(const LAS bf16x8*)(bl + HU_QH + ((mt * 4 + ks) * 64 + lane) * 16), sb[ks], acc);
            o[mt] = acc;
        }
        const LAS float* dl = dls + (c & 1) * 128;
#pragma unroll
        for (int i = 0; i < 8; ++i) {
            const f32x4 d = *(const LAS f32x4*)(dl + 16 * i + 4 * g4);
            const u32x2 uu = *(const LAS u32x2*)(myu + i * 8);
            S[i][0] = S[i][0] * d[0] + bflo(uu.x); S[i][1] = S[i][1] * d[1] + bfhi(uu.x); S[i][2] = S[i][2] * d[2] + bflo(uu.y); S[i][3] = S[i][3] * d[3] + bfhi(uu.y);
        }
        LAS float* rw = red + (c & 1) * 512;
#pragma unroll
        for (int mt = 0; mt < 4; ++mt)
#pragma unroll
            for (int r = 0; r < 4; ++r) { float s = row16_sum(o[mt][r] * o[mt][r]);
                if (q16 == 0) rw[(16 * mt + 4 * g4 + r) * 8 + wave] = s; }
        STAGE_T1(23);
        STAGE_T0(24);
        lds_barrier();
        asm volatile("s_waitcnt vmcnt(0)" ::: "memory");
        STAGE_T1(24);
        STAGE_T0(25);
        if (c + 1 < NCH && tid < 128) dls[((c + 1) & 1) * 128 + tid] = dnext;
#pragma unroll
        for (int mt = 0; mt < 4; ++mt)
#pragma unroll
            for (int r = 0; r < 4; ++r) { const int t = 16 * mt + 4 * g4 + r;
                const LAS f32x4* rp = (const LAS f32x4*)(rw + t * 8); const f32x4 r0 = rp[0], r1 = rp[1];
                const float ms = ((r0[0] + r0[1]) + (r0[2] + r0[3]) + (r1[0] + r1[1]) + (r1[2] + r1[3])) * (1.f / 128.f);
                mix[(trow0 + t) * D + 512 + h * 128 + v] = (bf16)f2bf(o[mt][r] * rsqrtf(ms + RMS_EPS) * gain * gate[mt][r]); }
        lds_barrier();
        STAGE_T1(25);
    }
}
constexpr int RU_L = 0, RU_RM = 8192, RU_NT = 16384, RU_YT = 24576, RU_G = 32768, RU_VB = 40960, RU_BYTES = 49152;
constexpr int RL_TDW = 0, RL_DA = 9216, RL_SDG = 18432;
constexpr int RL_A = 0, RL_CUM = 17408;
constexpr int RL_AAK = 0, RL_ARB = 9216, RL_ARK = 18432;
constexpr int RL_RAW = 36864, RAW_STRIDE = 400;
constexpr int RL_X2T = 27648;
constexpr int RL_TT = 36864, RL_PT = 46080;
constexpr int RL_AABH = 62976;
constexpr int RL_AT = 79360, RL_BT = 88576, RL_KT = 97792, RL_RT = 107008;
constexpr int RL_WT = RL_BT, RL_UT = RL_KT;
constexpr int RL_BHT = 116224, RL_KHT = 125440, RL_VT = 134656;
constexpr int RL_SEG = 143872;
constexpr int RL_ATT = 143872;
constexpr int RL_TM = 153088;
constexpr int FS = 272;

DEV void lr_item(int tid, int i, int& t, int& ch8) { if (i < 2) { t = tid >> 3; ch8 = 8 * i + (tid & 7); } else { const int idx = tid + (i - 2) * NTHR; t = idx >> 4; ch8 = 16 + (idx & 15); } }
DEV void rwkv_issue(int unit, const bf16* p, int tid, v4u (&rawv)[4], v4u (&curv)[4], v4u (&prvv)[4]) {
    const int c = unit & 31, h = (unit >> 5) & 7, b = unit >> 8;
    const size_t trow0 = (size_t)b * SEQ + (size_t)c * CH;
#pragma unroll
    for (int i = 0; i < 4; ++i) { const int it = tid + i * NTHR, row = it / 24, ch8 = it % 24, part = ch8 >> 3, cc = ch8 & 7;
        rawv[i] = (v4u){0u, 0u, 0u, 0u};
        if (it < 65 * 24 && (row > 0 || c > 0)) rawv[i] = *(const v4u*)(p + (trow0 + row - 1) * DIN + part * 512 + h * 64 + cc * 8); }
#pragma unroll
    for (int i = 0; i < 4; ++i) { int t, ch8; lr_item(tid, i, t, ch8);
        const bf16* src = p + (trow0 + t) * DIN + 1536 + ch8 * 8;
        curv[i] = *(const v4u*)src; prvv[i] = (v4u){0u, 0u, 0u, 0u};
        if (t > 0 || c > 0) prvv[i] = *(const v4u*)(src - DIN); }
}
DEV void rwkv_unitA(int unit, const bf16* p, const float* mu, const float* w0, const float* a0, const float* k_k, const float* k_a, const float* r_k,
                    const bf16* wupT, const bf16* aupT, const bf16* gupT, unsigned char* iar, float* gcr, LAS unsigned char* lds, int tid0, unsigned long long& tacc, v4u (&rawv)[4], v4u (&curv)[4], v4u (&prvv)[4], int next_unit) {
    const int c = unit & 31, h = (unit >> 5) & 7, b = unit >> 8;
    const size_t trow0 = (size_t)b * SEQ + (size_t)c * CH;
    unsigned char* uo = iar + (size_t)unit * RU_BYTES;
    bf16x8 fw[2][2], fa[2][2], fg[2][4]; f32x4 w0v[2], a0v[2];
    STAGE_T0(1);
    { int tid = tid0; asm volatile("" : "+v"(tid)); const int lane = tid & 63, wave = __builtin_amdgcn_readfirstlane(tid >> 6), q16 = lane & 15, g4 = lane >> 4; (void)lane; (void)wave; (void)q16; (void)g4;
    {
        { const int mt_ = wave >> 1; (void)mt_;
#pragma unroll
          for (int j = 0; j < 2; ++j) { const int nt = 2 * (wave & 1) + j; const int chrow = h * 64 + 16 * nt + q16;
#pragma unroll
              for (int ks = 0; ks < 2; ++ks) { fw[j][ks] = *(const bf16x8*)(wupT + chrow * 64 + ks * 32 + g4 * 8); fa[j][ks] = *(const bf16x8*)(aupT + chrow * 64 + ks * 32 + g4 * 8); }
#pragma unroll
              for (int ks = 0; ks < 4; ++ks) fg[j][ks] = *(const bf16x8*)(gupT + chrow * 128 + ks * 32 + g4 * 8);
              w0v[j] = *(const f32x4*)(w0 + h * 64 + 16 * nt + 4 * g4); a0v[j] = *(const f32x4*)(a0 + h * 64 + 16 * nt + 4 * g4); } }
#pragma unroll
        for (int i = 0; i < 4; ++i) { const int it = tid + i * NTHR, row = it / 24, ch8 = it % 24;
            if (it < 65 * 24) *(LAS v4u*)(lds + RL_RAW + row * RAW_STRIDE + ch8 * 16) = rawv[i]; }
#pragma unroll
        for (int i = 0; i < 4; ++i) { int t, ch8; lr_item(tid, i, t, ch8);
            const v4u cur = curv[i], prv = prvv[i];
            unsigned o[4];
#pragma unroll
            for (int e2 = 0; e2 < 4; ++e2) { const int col = 1536 + ch8 * 8 + 2 * e2;
                float x0 = bflo(cur[e2]), x1 = bfhi(cur[e2]); x0 += mu[col] * (bflo(prv[e2]) - x0); x1 += mu[col + 1] * (bfhi(prv[e2]) - x1);
                if (i == 0) { x0 = tanhf_(x0); x1 = tanhf_(x1); } else if (i >= 2) { x0 = sigmoidf_(x0); x1 = sigmoidf_(x1); }
                o[e2] = cvt_pk_bf16(x0, x1); }
            LAS unsigned char* dst = i == 0 ? lds + RL_TDW + t * SA64 + ch8 * 16 : (i == 1 ? lds + RL_DA + t * SA64 + (ch8 - 8) * 16 : lds + RL_SDG + t * SA128 + (ch8 - 16) * 16);
            *(LAS v4u*)dst = (v4u){o[0], o[1], o[2], o[3]}; }
        if (next_unit >= 0) rwkv_issue(next_unit, p, tid, rawv, curv, prvv);
    }
    lds_barrier();
    }
    STAGE_T1(1);
    STAGE_T0(2);
    { int tid = tid0; asm volatile("" : "+v"(tid)); const int lane = tid & 63, wave = __builtin_amdgcn_readfirstlane(tid >> 6), q16 = lane & 15, g4 = lane >> 4; (void)lane; (void)wave; (void)q16; (void)g4;
    {
        const int mt = wave >> 1;
        f32x4 zw[2], za[2], zg[2];
#pragma unroll
        for (int j = 0; j < 2; ++j) {
            f32x4 aw = (f32x4){0.f, 0.f, 0.f, 0.f}, aa = aw, ag = aw;
#pragma unroll
            for (int ks = 0; ks < 2; ++ks) {
                aw = mfma16(fw[j][ks], ldfrag(lds + RL_TDW, 16 * mt + q16, SA64, ks * 64 + g4 * 16), aw);
                aa = mfma16(fa[j][ks], ldfrag(lds + RL_DA, 16 * mt + q16, SA64, ks * 64 + g4 * 16), aa); }
#pragma unroll
            for (int ks = 0; ks < 4; ++ks) ag = mfma16(ldfrag(lds + RL_SDG, 16 * mt + q16, SA128, ks * 64 + g4 * 16), fg[j][ks], ag);
            zw[j] = aw; za[j] = aa; zg[j] = ag; }
        lds_barrier();
#pragma unroll
        for (int j = 0; j < 2; ++j) { const int nt = 2 * (wave & 1) + j, t = 16 * mt + q16, ch = 16 * nt + 4 * g4;
            f32x4 ldv, av;
#pragma unroll
            for (int r = 0; r < 4; ++r) { const float nz = -(zw[j][r] + w0v[j][r]), sp = fmaxf(nz, 0.f) + __logf(1.0f + __expf(-fabsf(nz)));
                ldv[r] = -__expf(-sp - 0.5f); av[r] = sigmoidf_(za[j][r] + a0v[j][r]); }
            *(LAS f32x4*)(lds + RL_CUM + t * FS + ch * 4) = ldv; *(LAS f32x4*)(lds + RL_A + t * FS + ch * 4) = av;
            *(u32x2*)(uo + RU_G + ((nt * 64 + lane) * 4 + mt) * 8) = (u32x2){cvt_pk_bf16(zg[j][0], zg[j][1]), cvt_pk_bf16(zg[j][2], zg[j][3])}; }
    }
    lds_barrier();
    }
    STAGE_T1(2);
    STAGE_T0(3);
    { int tid = tid0; asm volatile("" : "+v"(tid)); const int lane = tid & 63, wave = __builtin_amdgcn_readfirstlane(tid >> 6), q16 = lane & 15, g4 = lane >> 4; (void)lane; (void)wave; (void)q16; (void)g4;
    {
        const int ch = tid & 63, seg = tid >> 6; LAS float* segt = (LAS float*)(lds + RL_SEG);
        float loc[8]; float a = 0.f;
#pragma unroll
        for (int i = 0; i < 8; ++i) { a += *(LAS float*)(lds + RL_CUM + (8 * seg + i) * FS + ch * 4); loc[i] = a; }
        segt[seg * 64 + ch] = a;
        lds_barrier();
        float off = 0.f;
#pragma unroll
        for (int s2 = 0; s2 < 7; ++s2) if (s2 < seg) off += segt[s2 * 64 + ch];
#pragma unroll
        for (int i = 0; i < 8; ++i) *(LAS float*)(lds + RL_CUM + (8 * seg + i) * FS + ch * 4) = loc[i] + off;
    }
    lds_barrier();
    }
    STAGE_T1(3);
    STAGE_T0(4);
    { int tid = tid0; asm volatile("" : "+v"(tid)); const int lane = tid & 63, wave = __builtin_amdgcn_readfirstlane(tid >> 6), q16 = lane & 15, g4 = lane >> 4; (void)lane; (void)wave; (void)q16; (void)g4;
    {
        const int t = tid >> 3, ch0 = 8 * (tid & 7);
        const LAS unsigned char* rawc = lds + RL_RAW + (t + 1) * RAW_STRIDE, *rawp = lds + RL_RAW + t * RAW_STRIDE;
        float xr[8], xk[8], xv[8];
#pragma unroll
        for (int part = 0; part < 3; ++part) { const v4u cu = *(const LAS v4u*)(rawc + part * 128 + ch0 * 2), pv = *(const LAS v4u*)(rawp + part * 128 + ch0 * 2);
#pragma unroll
            for (int e2 = 0; e2 < 4; ++e2) { const int col = part * 512 + h * 64 + ch0 + 2 * e2;
                float x0 = bflo(cu[e2]), x1 = bfhi(cu[e2]); x0 += mu[col] * (bflo(pv[e2]) - x0); x1 += mu[col + 1] * (bfhi(pv[e2]) - x1);
                if (part == 0) { xr[2 * e2] = x0; xr[2 * e2 + 1] = x1; } else if (part == 1) { xk[2 * e2] = x0; xk[2 * e2 + 1] = x1; } else { xv[2 * e2] = x0; xv[2 * e2 + 1] = x1; } } }
        float kkp[8], ssq = 0.f;
#pragma unroll
        for (int e = 0; e < 8; ++e) { kkp[e] = xk[e] * k_k[h * 64 + ch0 + e]; ssq += kkp[e] * kkp[e]; }
        ssq = oct_sum(ssq);
        const float inv = fminf(__builtin_amdgcn_rsqf(ssq), 1.0f / L2_EPS);
        float bon = 0.f;
        unsigned oa[4], ob[4], ok[4], orr[4];
        float bh[8], kh[8];
#pragma unroll
        for (int e = 0; e < 8; ++e) { const int ch = ch0 + e;
            const float a = *(const LAS float*)(lds + RL_A + t * FS + ch * 4), cumt = *(const LAS float*)(lds + RL_CUM + t * FS + ch * 4);
            const float cump = t > 0 ? *(const LAS float*)(lds + RL_CUM + (t - 1) * FS + ch * 4) : 0.f, cumC = *(const LAS float*)(lds + RL_CUM + 63 * FS + ch * 4);
            const float kk = kkp[e] * inv, kp = xk[e] * (1.f + (a - 1.f) * k_a[h * 64 + ch]), bb = kk * a;
            const float E = __expf(cumt), Ei = __builtin_amdgcn_rcpf(E), Ep = __expf(cump), EC = __expf(cumC - cumt);
            const float vat = -kk * Ep, vbt = bb * Ei, vkt = kp * Ei, vrt = xr[e] * E;
            bh[e] = bb * EC; kh[e] = kp * EC;
            bon += xr[e] * kp * r_k[h * 64 + ch];
            if (e & 1) { oa[e >> 1] |= f2bf(vat) << 16; ob[e >> 1] |= f2bf(vbt) << 16; ok[e >> 1] |= f2bf(vkt) << 16; orr[e >> 1] |= f2bf(vrt) << 16; }
            else { oa[e >> 1] = f2bf(vat); ob[e >> 1] = f2bf(vbt); ok[e >> 1] = f2bf(vkt); orr[e >> 1] = f2bf(vrt); }
            if (t == 63) gcr[(size_t)unit * 64 + ch] = E;
        }
        *(LAS v4u*)(lds + RL_AT + t * SA64 + ch0 * 2) = (v4u){oa[0], oa[1], oa[2], oa[3]};
        *(LAS v4u*)(lds + RL_BT + t * SA64 + ch0 * 2) = (v4u){ob[0], ob[1], ob[2], ob[3]};
        *(LAS v4u*)(lds + RL_KT + t * SA64 + ch0 * 2) = (v4u){ok[0], ok[1], ok[2], ok[3]};
        *(LAS v4u*)(lds + RL_RT + t * SA64 + ch0 * 2) = (v4u){orr[0], orr[1], orr[2], orr[3]};
#pragma unroll
        for (int e = 0; e < 8; ++e) { *(LAS bf16*)(lds + RL_BHT + (ch0 + e) * SA64 + t * 2) = (bf16)f2bf(bh[e]); *(LAS bf16*)(lds + RL_KHT + (ch0 + e) * SA64 + t * 2) = (bf16)f2bf(kh[e]);
            *(LAS bf16*)(lds + RL_VT + (ch0 + e) * SA64 + t * 2) = (bf16)f2bf(xv[e]);
            *(LAS bf16*)(lds + RL_ATT + (ch0 + e) * SA64 + t * 2) = (bf16)(e & 1 ? oa[e >> 1] >> 16 : oa[e >> 1] & 0xffffu); }
        bon = oct_sum(bon);
#pragma unroll
        for (int e = 0; e < 8; ++e) { const int ch = ch0 + e;
            *(bf16*)(uo + RU_VB + (((ch >> 4) * 64 + ((t & 15) >> 2) * 16 + (ch & 15)) * 4 + (t >> 4)) * 8 + (t & 3) * 2) = (bf16)f2bf(bon * xv[e]); }
    }
    lds_barrier();
    }
    STAGE_T1(4);
    STAGE_T0(5);
    { int tid = tid0; asm volatile("" : "+v"(tid)); const int lane = tid & 63, wave = __builtin_amdgcn_readfirstlane(tid >> 6), q16 = lane & 15, g4 = lane >> 4; (void)lane; (void)wave; (void)q16; (void)g4;
    for (int it = tid; it < 3 * 576; it += NTHR) { const int mtx = it / 576, o = (it % 576) * 16; *(LAS v4u*)(lds + (mtx == 0 ? RL_TM : (mtx == 1 ? RL_TT : RL_PT)) + o) = (v4u){0u, 0u, 0u, 0u}; }
    for (int ti = wave; ti < 16; ti += 8) {
        const int mt = ti >> 2, nt = ti & 3;
        f32x4 ab = (f32x4){0.f, 0.f, 0.f, 0.f}, ak = ab, rb = ab, rk = ab;
        if (nt <= mt) {
#pragma unroll
            for (int ks = 0; ks < 2; ++ks) { const int kb = ks * 64 + g4 * 16;
                const bf16x8 fb = ldfrag(lds + RL_BT, 16 * nt + q16, SA64, kb), fk = ldfrag(lds + RL_KT, 16 * nt + q16, SA64, kb), ga = ldfrag(lds + RL_AT, 16 * mt + q16, SA64, kb), gr = ldfrag(lds + RL_RT, 16 * mt + q16, SA64, kb);
                ab = mfma16(fb, ga, ab); ak = mfma16(fk, ga, ak); rb = mfma16(fb, gr, rb); rk = mfma16(fk, gr, rk); }
            if (nt == mt) {
#pragma unroll
                for (int r = 0; r < 4; ++r) { if (4 * g4 + r >= q16) { ab[r] = 0.f; ak[r] = 0.f; } if (4 * g4 + r > q16) { rb[r] = 0.f; rk[r] = 0.f; } } }
        }
        const int t = 16 * mt + q16, s0 = 16 * nt + 4 * g4;
        *(LAS u32x2*)(lds + RL_AABH + t * SA64 + s0 * 2) = (u32x2){cvt_pk_bf16(ab[0], ab[1]), cvt_pk_bf16(ab[2], ab[3])};
        *(LAS u32x2*)(lds + RL_AAK + t * SA64 + s0 * 2) = (u32x2){cvt_pk_bf16(ak[0], ak[1]), cvt_pk_bf16(ak[2], ak[3])};
        *(LAS u32x2*)(lds + RL_ARB + t * SA64 + s0 * 2) = (u32x2){cvt_pk_bf16(rb[0], rb[1]), cvt_pk_bf16(rb[2], rb[3])};
        *(LAS u32x2*)(lds + RL_ARK + t * SA64 + s0 * 2) = (u32x2){cvt_pk_bf16(rk[0], rk[1]), cvt_pk_bf16(rk[2], rk[3])};
    }
    lds_barrier();
    }
    STAGE_T1(5);
    STAGE_T0(6);
    { int tid = tid0; asm volatile("" : "+v"(tid)); const int lane = tid & 63, wave = __builtin_amdgcn_readfirstlane(tid >> 6), q16 = lane & 15, g4 = lane >> 4; (void)lane; (void)wave; (void)q16; (void)g4;
    for (int ti = wave; ti < 16; ti += 8) {
        const int mt = ti >> 2, nt = ti & 3;
        f32x4 acc = (f32x4){0.f, 0.f, 0.f, 0.f};
#pragma unroll
        for (int ks = 0; ks < 2; ++ks) acc = mfma16(ldfrag(lds + RL_AAK, 16 * mt + q16, SA64, ks * 64 + g4 * 16), ldfrag(lds + RL_VT, 16 * nt + q16, SA64, ks * 64 + g4 * 16), acc);
        *(LAS u32x2*)(lds + RL_X2T + (16 * nt + q16) * SA64 + (16 * mt + 4 * g4) * 2) = (u32x2){cvt_pk_bf16(acc[0], acc[1]), cvt_pk_bf16(acc[2], acc[3])};
    }
    lds_barrier();
    }
    STAGE_T1(6);
    STAGE_T0(7);
    { int tid = tid0; asm volatile("" : "+v"(tid)); const int lane = tid & 63, wave = __builtin_amdgcn_readfirstlane(tid >> 6), q16 = lane & 15, g4 = lane >> 4; (void)lane; (void)wave; (void)q16; (void)g4;
    if (wave == 0) {
        const int b4 = lane >> 4, cc = lane & 15;
        float x[16];
#pragma unroll
        for (int r = 0; r < 16; ++r) {
            const LAS unsigned char* arow = lds + RL_AABH + (16 * b4 + r) * SA64 + 32 * b4;
            const v4u a0 = *(const LAS v4u*)arow, a1 = *(const LAS v4u*)(arow + 16);
            float xr = (r == cc) ? 1.f : 0.f;
#pragma unroll
            for (int s2 = 0; s2 < 16; ++s2) if (s2 < r) { const unsigned w = s2 < 8 ? a0[s2 >> 1] : a1[(s2 - 8) >> 1]; xr += ((s2 & 1) ? bfhi(w) : bflo(w)) * x[s2]; }
            x[r] = xr;
        }
        LAS unsigned char* trow = lds + RL_TT + (16 * b4 + cc) * SA64 + 32 * b4;
        *(LAS v4u*)trow = (v4u){cvt_pk_bf16(x[0], x[1]), cvt_pk_bf16(x[2], x[3]), cvt_pk_bf16(x[4], x[5]), cvt_pk_bf16(x[6], x[7])};
        *(LAS v4u*)(trow + 16) = (v4u){cvt_pk_bf16(x[8], x[9]), cvt_pk_bf16(x[10], x[11]), cvt_pk_bf16(x[12], x[13]), cvt_pk_bf16(x[14], x[15])};
#pragma unroll
        for (int r = 0; r < 16; ++r) *(LAS bf16*)(lds + RL_TM + (16 * b4 + r) * SA64 + (16 * b4 + cc) * 2) = (bf16)f2bf(x[r]);
    }
    lds_barrier();
#define INV_LEVEL(mt, nt, ks1, ks2) do { \
        f32x4 pa = mfma16(ldfrag(lds + RL_AABH, 16 * (mt) + q16, SA64, (ks1) * 64 + g4 * 16), ldfrag(lds + RL_TT, 16 * (nt) + q16, SA64, (ks1) * 64 + g4 * 16), (f32x4){0.f, 0.f, 0.f, 0.f}); \
        *(LAS u32x2*)(lds + RL_PT + (16 * (nt) + q16) * SA64 + (16 * (mt) + 4 * g4) * 2) = (u32x2){cvt_pk_bf16(pa[0], pa[1]), cvt_pk_bf16(pa[2], pa[3])}; } while (0)
#define INV_APPLY(mt, nt, ks2) do { \
        f32x4 ta = mfma16(ldfrag(lds + RL_TM, 16 * (mt) + q16, SA64, (ks2) * 64 + g4 * 16), ldfrag(lds + RL_PT, 16 * (nt) + q16, SA64, (ks2) * 64 + g4 * 16), (f32x4){0.f, 0.f, 0.f, 0.f}); \
        *(LAS u32x2*)(lds + RL_TT + (16 * (nt) + q16) * SA64 + (16 * (mt) + 4 * g4) * 2) = (u32x2){cvt_pk_bf16(ta[0], ta[1]), cvt_pk_bf16(ta[2], ta[3])}; \
        _Pragma("unroll") for (int r = 0; r < 4; ++r) *(LAS bf16*)(lds + RL_TM + (16 * (mt) + 4 * g4 + r) * SA64 + (16 * (nt) + q16) * 2) = (bf16)f2bf(ta[r]); } while (0)
    if (wave < 2) { const int mt = 2 * wave + 1, nt = 2 * wave; INV_LEVEL(mt, nt, wave, wave); }
    lds_barrier();
    if (wave < 2) { const int mt = 2 * wave + 1, nt = 2 * wave; INV_APPLY(mt, nt, wave); }
    lds_barrier();
    if (wave < 4) { const int mt = 2 + (wave >> 1), nt = wave & 1; INV_LEVEL(mt, nt, 0, 0); }
    lds_barrier();
    if (wave < 4) { const int mt = 2 + (wave >> 1), nt = wave & 1; INV_APPLY(mt, nt, 1); }
    lds_barrier();
#undef INV_LEVEL
#undef INV_APPLY
    for (int ti = wave; ti < 32; ti += 8) {
        const int which = ti >> 4, mt = (ti >> 2) & 3, nt = ti & 3;
        f32x4 acc = (f32x4){0.f, 0.f, 0.f, 0.f};
#pragma unroll
        for (int ks = 0; ks < 2; ++ks) acc = mfma16(ldfrag(lds + RL_TM, 16 * mt + q16, SA64, ks * 64 + g4 * 16), ldfrag(lds + (which ? RL_X2T : RL_ATT), 16 * nt + q16, SA64, ks * 64 + g4 * 16), acc);
        *(LAS u32x2*)(lds + (which ? RL_UT : RL_WT) + (16 * nt + q16) * SA64 + (16 * mt + 4 * g4) * 2) = (u32x2){cvt_pk_bf16(acc[0], acc[1]), cvt_pk_bf16(acc[2], acc[3])};
    }
    lds_barrier();
    }
    STAGE_T1(7);
    STAGE_T0(8);
    { int tid = tid0; asm volatile("" : "+v"(tid)); const int lane = tid & 63, wave = __builtin_amdgcn_readfirstlane(tid >> 6), q16 = lane & 15, g4 = lane >> 4; (void)lane; (void)wave; (void)q16; (void)g4;
    for (int ti = wave; ti < 16; ti += 8) {
        const int mt = ti >> 2, nt = ti & 3;
        f32x4 aL = (f32x4){0.f, 0.f, 0.f, 0.f}, aR = aL, aN = aL, aY = aL;
#pragma unroll
        for (int ks = 0; ks < 2; ++ks) { const int kb = ks * 64 + g4 * 16;
            const bf16x8 wt_n = ldfrag(lds + RL_WT, 16 * nt + q16, SA64, kb);
            aL = mfma16(wt_n, ldfrag(lds + RL_BHT, 16 * mt + q16, SA64, kb), aL);
            aR = mfma16(wt_n, ldfrag(lds + RL_ARB, 16 * mt + q16, SA64, kb), aR);
            const bf16x8 ut_m = ldfrag(lds + RL_UT, 16 * mt + q16, SA64, kb), vt_m = ldfrag(lds + RL_VT, 16 * mt + q16, SA64, kb);
            aN = mfma16(ldfrag(lds + RL_BHT, 16 * nt + q16, SA64, kb), ut_m, aN); aN = mfma16(ldfrag(lds + RL_KHT, 16 * nt + q16, SA64, kb), vt_m, aN);
            aY = mfma16(ldfrag(lds + RL_ARB, 16 * nt + q16, SA64, kb), ut_m, aY); aY = mfma16(ldfrag(lds + RL_ARK, 16 * nt + q16, SA64, kb), vt_m, aY);
        }
        const int row = 16 * mt + q16, col0 = 16 * nt + 4 * g4;
        const u32x2 rt = *(const LAS u32x2*)(lds + RL_RT + row * SA64 + col0 * 2);
        aR[0] += bflo(rt.x); aR[1] += bfhi(rt.x); aR[2] += bflo(rt.y); aR[3] += bfhi(rt.y);
        *(u32x2*)(uo + RU_L + ((mt * 2 + (nt >> 1)) * 64 + lane) * 16 + (nt & 1) * 8) = (u32x2){cvt_pk_bf16(aL[0], aL[1]), cvt_pk_bf16(aL[2], aL[3])};
        *(u32x2*)(uo + RU_RM + ((mt * 2 + (nt >> 1)) * 64 + lane) * 16 + (nt & 1) * 8) = (u32x2){cvt_pk_bf16(aR[0], aR[1]), cvt_pk_bf16(aR[2], aR[3])};
        *(u32x2*)(uo + RU_NT + ((mt * 64 + lane) * 4 + nt) * 8) = (u32x2){cvt_pk_bf16(aN[0], aN[1]), cvt_pk_bf16(aN[2], aN[3])};
        *(u32x2*)(uo + RU_YT + ((mt * 64 + lane) * 4 + nt) * 8) = (u32x2){cvt_pk_bf16(aY[0], aY[1]), cvt_pk_bf16(aY[2], aY[3])};
    }
    lds_barrier();
    }
    STAGE_T1(8);
}

DEV void rwkv_seqB(int bh, const unsigned char* iar, const float* gcr, const float* ln_w, const float* ln_b, bf16* mix, LAS unsigned char* lds, int tid) {
    const int lane = tid & 63, wave = __builtin_amdgcn_readfirstlane(tid >> 6), q16 = lane & 15, g4 = lane >> 4;
    const int h = bh & 7, b = bh >> 3, w = wave & 3, v = 16 * w + q16, chg = h * 64 + v;
    const bool act = wave < 4;
    const float lw = ln_w[chg], lb = ln_b[chg];
    LAS float* red = (LAS float*)(lds + 2 * RU_BYTES);
    f32x4 S[4];
#pragma unroll
    for (int i = 0; i < 4; ++i) S[i] = (f32x4){0.f, 0.f, 0.f, 0.f};
    blob_to_lds(iar + (size_t)(bh * NCH) * RU_BYTES, lds, RU_BYTES, wave, lane);
    f32x4 gcn[4];
#pragma unroll
    for (int kt = 0; kt < 4; ++kt) gcn[kt] = *(const f32x4*)(gcr + (size_t)(bh * NCH) * 64 + 16 * kt + 4 * g4);
    asm volatile("s_waitcnt vmcnt(0)" ::: "memory");
    lds_barrier();
    for (int c = 0; c < NCH; ++c) {
        const int unit = bh * NCH + c;
        const LAS unsigned char* bl = lds + (c & 1) * RU_BYTES;
        const size_t trow0 = (size_t)b * SEQ + (size_t)c * CH;
        f32x4 gc[4];
#pragma unroll
        for (int kt = 0; kt < 4; ++kt) gc[kt] = gcn[kt];
        if (c + 1 < NCH) { blob_to_lds(iar + (size_t)(unit + 1) * RU_BYTES, lds + ((c + 1) & 1) * RU_BYTES, RU_BYTES, wave, lane);
#pragma unroll
            for (int kt = 0; kt < 4; ++kt) gcn[kt] = *(const f32x4*)(gcr + (size_t)(unit + 1) * 64 + 16 * kt + 4 * g4); }
        f32x4 y[4];
        if (act) {
            bf16x8 sb[2];
#pragma unroll
            for (int ks = 0; ks < 2; ++ks) { const v4u t4 = (v4u){cvt_pk_bf16(S[2 * ks][0], S[2 * ks][1]), cvt_pk_bf16(S[2 * ks][2], S[2 * ks][3]), cvt_pk_bf16(S[2 * ks + 1][0], S[2 * ks + 1][1]), cvt_pk_bf16(S[2 * ks + 1][2], S[2 * ks + 1][3])};
                sb[ks] = __builtin_bit_cast(bf16x8, t4); }
            const LAS unsigned char* myc = bl + (w * 64 + lane) * 32;
#pragma unroll
            for (int mt = 0; mt < 4; ++mt) {
                const u32x2 yi = *(const LAS u32x2*)(myc + RU_YT + mt * 8);
                f32x4 acc = (f32x4){bflo(yi.x), bfhi(yi.x), bflo(yi.y), bfhi(yi.y)};
#pragma unroll
                for (int ks = 0; ks < 2; ++ks) acc = mfma16(*(const LAS bf16x8*)(bl + RU_RM + ((mt * 2 + ks) * 64 + lane) * 16), sb[ks], acc);
                y[mt] = acc;
            }
            f32x4 Sn[4];
#pragma unroll
            for (int kt = 0; kt < 4; ++kt) {
                const u32x2 ni = *(const LAS u32x2*)(myc + RU_NT + kt * 8);
                f32x4 acc = (f32x4){bflo(ni.x) + gc[kt][0] * S[kt][0], bfhi(ni.x) + gc[kt][1] * S[kt][1], bflo(ni.y) + gc[kt][2] * S[kt][2], bfhi(ni.y) + gc[kt][3] * S[kt][3]};
#pragma unroll
                for (int ks = 0; ks < 2; ++ks) acc = mfma16(*(const LAS bf16x8*)(bl + RU_L + ((kt * 2 + ks) * 64 + lane) * 16), sb[ks], acc);
                Sn[kt] = acc;
            }
#pragma unroll
            for (int kt = 0; kt < 4; ++kt) S[kt] = Sn[kt];
            LAS float* rw = red + (c & 1) * 512;
#pragma unroll
            for (int mt = 0; mt < 4; ++mt)
#pragma unroll
                for (int r = 0; r < 4; ++r) { float s1 = y[mt][r], s2 = s1 * s1;
                    s1 = row16_sum(s1); s2 = row16_sum(s2);
                    if (q16 == 0) { const int t = 16 * mt + 4 * g4 + r; rw[t * 8 + w * 2] = s1; rw[t * 8 + w * 2 + 1] = s2; } }
        }
        lds_barrier();
        asm volatile("s_waitcnt vmcnt(0)" ::: "memory");
        if (act) {
            const LAS float* rr = red + (c & 1) * 512;
            const LAS unsigned char* myc = bl + (w * 64 + lane) * 32;
#pragma unroll
            for (int mt = 0; mt < 4; ++mt) {
                const u32x2 gi = *(const LAS u32x2*)(myc + RU_G + mt * 8), vi = *(const LAS u32x2*)(myc + RU_VB + mt * 8);
                const float gv[4] = {bflo(gi.x), bfhi(gi.x), bflo(gi.y), bfhi(gi.y)}, vb[4] = {bflo(vi.x), bfhi(vi.x), bflo(vi.y), bfhi(vi.y)};
#pragma unroll
                for (int r = 0; r < 4; ++r) { const int t = 16 * mt + 4 * g4 + r;
                    const LAS f32x4* rp = (const LAS f32x4*)(rr + t * 8); const f32x4 r0 = rp[0], r1 = rp[1];
                    const float mean = ((r0[0] + r0[2]) + (r1[0] + r1[2])) * (1.f / 64.f), ex2 = ((r0[1] + r0[3]) + (r1[1] + r1[3])) * (1.f / 64.f);
                    const float var = fmaxf(ex2 - mean * mean, 0.f);
                    mix[(trow0 + t) * D + chg] = (bf16)f2bf(((y[mt][r] - mean) * rsqrtf(var + GN_EPS) * lw + lb + vb[r]) * gv[r]); }
            }
        }
        lds_barrier();
    }
}
DEV void ph_router(const float* h, const float* g2, const float* wrt2, const float* bg, const float* be, bf16* hn,
                   int* hist, int* tok_e, int* tok_pos, float* tok_gate, LAS float* lds_f, int blk, int G, int wave, int lane, unsigned long long& tacc) {
    const int q16 = lane & 15, g4 = lane >> 4, tw = wave & 3, kh = wave >> 2;
    LAS float* part = lds_f + tw * 1024;
    LAS float* lg = lds_f + 4096 + tw * 1024;
    LAS int* lcnt = (LAS int*)(lds_f + 8192);
    LAS float* lbias = lds_f + 8192 + 32;
    if (threadIdx.x < 32) lcnt[threadIdx.x] = 0;
    if (threadIdx.x < 36) lbias[threadIdx.x] = threadIdx.x < 32 ? be[threadIdx.x] : bg[threadIdx.x - 32];
    __syncthreads();
    f32x4 gg[4];
#pragma unroll
    for (int j = 0; j < 4; ++j) gg[j] = ((const f32x4*)g2)[lane + 64 * j];
    for (int tile = blk * 4 + tw; tile < T / 16; tile += G * 4) {
        const float* hrow = h + (size_t)(tile * 16 + q16) * D + 4 * g4 + kh * 512;
        const float* w0p = wrt2 + (size_t)q16 * D + 4 * g4 + kh * 512;
        f32x4 acc0 = (f32x4){0.f, 0.f, 0.f, 0.f}, acc1 = acc0, acc2 = acc0; float ssq = 0.f;
        f32x4 A0[4], B00[4], B01[4], B02[4], A1[4], B10[4], B11[4], B12[4];
#define RT_LOAD(Ax, Bx0, Bx1, Bx2, grp) _Pragma("unroll") for (int i = 0; i < 4; ++i) { const int k0 = (grp) * 64 + i * 16; Ax[i] = *(const f32x4*)(hrow + k0); Bx0[i] = *(const f32x4*)(w0p + k0); Bx1[i] = *(const f32x4*)(w0p + 16 * D + k0); Bx2[i] = *(const f32x4*)(w0p + 32 * D + k0); }
#define RT_COMP(Ax, Bx0, Bx1, Bx2) _Pragma("unroll") for (int i = 0; i < 4; ++i) { const f32x4 a = Ax[i]; ssq += (a[0] * a[0] + a[1] * a[1]) + (a[2] * a[2] + a[3] * a[3]); \
            _Pragma("unroll") for (int j = 0; j < 4; ++j) { acc0 = __builtin_amdgcn_mfma_f32_16x16x4f32(Bx0[i][j], a[j], acc0, 0, 0, 0); acc1 = __builtin_amdgcn_mfma_f32_16x16x4f32(Bx1[i][j], a[j], acc1, 0, 0, 0); acc2 = __builtin_amdgcn_mfma_f32_16x16x4f32(Bx2[i][j], a[j], acc2, 0, 0, 0); } }
        STAGE_T0(19);
        RT_LOAD(A0, B00, B01, B02, 0)
#pragma nounroll
        for (int gp = 0; gp < 8; gp += 2) {
            RT_LOAD(A1, B10, B11, B12, gp + 1)
            RT_COMP(A0, B00, B01, B02)
            if (gp + 2 < 8) { RT_LOAD(A0, B00, B01, B02, gp + 2) }
            RT_COMP(A1, B10, B11, B12)
        }
#undef RT_LOAD
#undef RT_COMP
        asm volatile("" : "+v"(acc0), "+v"(acc1), "+v"(acc2)); STAGE_T1(19);
        STAGE_T0(20);
        ssq += __shfl_xor(ssq, 16); ssq += __shfl_xor(ssq, 32);
        if (kh == 1) { *(LAS f32x4*)(part + q16 * 52 + 4 * g4) = acc0; *(LAS f32x4*)(part + q16 * 52 + 16 + 4 * g4) = acc1; *(LAS f32x4*)(part + q16 * 52 + 32 + 4 * g4) = acc2; if (g4 == 0) part[q16 * 52 + 48] = ssq; }
        __syncthreads();
        if (kh == 0) {
            acc0 += *(const LAS f32x4*)(part + q16 * 52 + 4 * g4); acc1 += *(const LAS f32x4*)(part + q16 * 52 + 16 + 4 * g4); acc2 += *(const LAS f32x4*)(part + q16 * 52 + 32 + 4 * g4); ssq += part[q16 * 52 + 48];
            const float rstd = rsqrtf(ssq * (1.f / D) + RMS_EPS);
            *(LAS f32x4*)(lg + q16 * 48 + 4 * g4) = acc0 * rstd; *(LAS f32x4*)(lg + q16 * 48 + 16 + 4 * g4) = acc1 * rstd; *(LAS f32x4*)(lg + q16 * 48 + 32 + 4 * g4) = acc2 * rstd;
            if (g4 == 0) part[q16 * 52 + 49] = rstd;
            asm volatile("s_waitcnt lgkmcnt(0)" ::: "memory");
            if (lane < 16) {
                const int t = tile * 16 + lane; const LAS float* L = lg + lane * 48;
                float gl[4]; float gm = -1e30f; int gi = 0;
#pragma unroll
                for (int g = 0; g < 4; ++g) { gl[g] = L[32 + g] + lbias[32 + g]; if (gl[g] > gm) { gm = gl[g]; gi = g; } }
                float gs = 0.f;
#pragma unroll
                for (int g = 0; g < 4; ++g) gs += __expf(gl[g] - gm);
                const float g_w = 1.f / gs;
                float el[8];
#pragma unroll
                for (int j = 0; j < 8; ++j) el[j] = L[gi * 8 + j] + lbias[gi * 8 + j];
                float m1 = -1e30f; int i1 = 0;
#pragma unroll
                for (int j = 0; j < 8; ++j) if (el[j] > m1) { m1 = el[j]; i1 = j; }
                float m2 = -1e30f; int i2 = 0;
#pragma unroll
                for (int j = 0; j < 8; ++j) if (j != i1 && el[j] > m2) { m2 = el[j]; i2 = j; }
                const float p2 = __expf(m2 - m1), w1 = 1.f / (1.f + p2), w2 = p2 / (1.f + p2);
                const int e1 = gi * 8 + i1, e2 = gi * 8 + i2;
                const int q1 = __hip_atomic_fetch_add(lcnt + e1, 1, __ATOMIC_RELAXED, __HIP_MEMORY_SCOPE_WORKGROUP), q2 = __hip_atomic_fetch_add(lcnt + e2, 1, __ATOMIC_RELAXED, __HIP_MEMORY_SCOPE_WORKGROUP);
                tok_e[2 * t] = e1; tok_e[2 * t + 1] = e2; tok_pos[2 * t] = (int)q1; tok_pos[2 * t + 1] = (int)q2; tok_gate[2 * t] = g_w * w1; tok_gate[2 * t + 1] = g_w * w2;
            }
        }
        __syncthreads();
        STAGE_T1(20);
        STAGE_T0(21);
#pragma unroll 4
        for (int r8 = 0; r8 < 8; ++r8) { const int r = kh * 8 + r8;
            const float rs = part[r * 52 + 49];
            const f32x4* xr = (const f32x4*)(h + (size_t)(tile * 16 + r) * D) + lane;
            unsigned long long* o8 = (unsigned long long*)(hn + (size_t)(tile * 16 + r) * D) + lane;
#pragma unroll
            for (int j = 0; j < 4; ++j) { const f32x4 v = xr[64 * j] * rs * gg[j]; o8[64 * j] = (unsigned long long)cvt_pk_bf16(v.x, v.y) | ((unsigned long long)cvt_pk_bf16(v.z, v.w) << 32); }
        }
        __syncthreads();
        STAGE_T1(21);
    }
    if (threadIdx.x < 32) hist[blk * 32 + threadIdx.x] = lcnt[threadIdx.x];
}
DEV void ph_scatter(const bf16* hn, const int* hist, const int* tok_e, const int* tok_pos, int* misc, bf16* xg, int* tok_slot, LAS int* lsm, int G, int gw, int NGW, int lane, int tid) {
    LAS int* pre = lsm;
    LAS int* offs = lsm + 256 * 32;
    LAS int* segs = offs + 32;
    __syncthreads();
    { const int e = tid & 31, sg = tid >> 5; int a = 0;
      const int per = (G + 15) >> 4;
      for (int i = 0; i < per; ++i) { const int b = sg * per + i; if (b < G) { const int v = hist[b * 32 + e]; pre[b * 32 + e] = a; a += v; } }
      segs[sg * 32 + e] = a; }
    __syncthreads();
    { const int e = tid & 31, sg = tid >> 5; int o = 0;
      for (int s2 = 0; s2 < sg; ++s2) o += segs[s2 * 32 + e];
      const int per = (G + 15) >> 4;
      for (int i = 0; i < per; ++i) { const int b = sg * per + i; if (b < G) pre[b * 32 + e] += o; } }
    __syncthreads();
    if (tid == 0) { int off = 0, nt = 0; const bool wr = blockIdx.x == 0;
        for (int e = 0; e < NE; ++e) { int c = 0; for (int s2 = 0; s2 < 16; ++s2) c += segs[s2 * 32 + e];
            const int tiles = (c + 255) >> 8; offs[e] = off;
            if (wr) for (int i = 0; i < tiles; ++i) misc[64 + nt + i] = e;
            nt += tiles; off += tiles * 256; }
        if (wr) misc[0] = nt; }
    __syncthreads();
    for (int t = gw; t < T; t += NGW) {
        const v4u* src = (const v4u*)(hn + (size_t)t * D) + lane;
        const v4u a = src[0], b = src[64];
        const int bsrc = (t >> 6) % G;
#pragma unroll
        for (int k = 0; k < 2; ++k) { const int e = tok_e[2 * t + k], slot = offs[e] + pre[bsrc * 32 + e] + tok_pos[2 * t + k];
            v4u* dst = (v4u*)(xg + (size_t)slot * D) + lane; dst[0] = a; dst[64] = b;
            if (lane == 0) tok_slot[2 * t + k] = slot; }
    }
}
DEV void ph_final(float* h, const bf16* yo, const int* tok_slot, const float* tok_gate, const float* gf, int gw, int NGW, int lane) {
    for (int t = gw; t < T; t += NGW) {
        f32x4* xr = (f32x4*)(h + (size_t)t * D) + lane; const f32x4* gr = (const f32x4*)gf + lane;
        const int s1 = tok_slot[2 * t], s2 = tok_slot[2 * t + 1]; const float g1 = tok_gate[2 * t], g2 = tok_gate[2 * t + 1];
        const unsigned long long* y1 = (const unsigned long long*)(yo + (size_t)s1 * D) + lane; const unsigned long long* y2 = (const unsigned long long*)(yo + (size_t)s2 * D) + lane;
        f32x4 v[4]; float s = 0.f;
#pragma unroll
        for (int j = 0; j < 4; ++j) { v[j] = xr[64 * j]; const unsigned long long a = y1[64 * j], b = y2[64 * j];
            v[j].x += g1 * bf2f((bf16)(a & 0xffff)) + g2 * bf2f((bf16)(b & 0xffff));
            v[j].y += g1 * bf2f((bf16)((a >> 16) & 0xffff)) + g2 * bf2f((bf16)((b >> 16) & 0xffff));
            v[j].z += g1 * bf2f((bf16)((a >> 32) & 0xffff)) + g2 * bf2f((bf16)((b >> 32) & 0xffff));
            v[j].w += g1 * bf2f((bf16)(a >> 48)) + g2 * bf2f((bf16)(b >> 48));
            s += (v[j].x * v[j].x + v[j].y * v[j].y) + (v[j].z * v[j].z + v[j].w * v[j].w); }
        const float rstd = rsqrtf(wave_sum(s) * (1.f / D) + RMS_EPS);
#pragma unroll
        for (int j = 0; j < 4; ++j) xr[64 * j] = v[j] * rstd * gr[64 * j];
    }
}

#ifndef MK_N_LAUNCHES
#define MK_N_LAUNCHES 1
#endif
constexpr int N_PHASES = 11;
struct Args { const float* in[27]; float* out; unsigned char* ws; int ph_lo, ph_hi; };
__global__ void __launch_bounds__(NTHR, 2) mega_kernel(Args args) {
    extern __shared__ __attribute__((aligned(16))) unsigned char lds_raw[];
    LAS unsigned char* lds = (LAS unsigned char*)lds_raw;
    volatile LAS unsigned* MISC = (volatile LAS unsigned*)(lds + MISC_OFF);
    const int tid = threadIdx.x, lane = tid & 63, wave = __builtin_amdgcn_readfirstlane(tid >> 6);
    const int G = gridDim.x, blk = blockIdx.x, gw = blk * NWAVES + wave, NGW = G * NWAVES;
    unsigned char* ws = args.ws; float* out = args.out; const float* const* in = args.in;
    bf16 *win_t = (bf16*)(ws + WS_WIN), *wout_t = (bf16*)(ws + WS_WOUT), *wgu_t = (bf16*)(ws + WS_WGU), *wd_t = (bf16*)(ws + WS_WD);
    bf16 *xn = (bf16*)(ws + WS_XN), *p = (bf16*)(ws + WS_P), *xg = (bf16*)(ws + WS_XG), *H = (bf16*)(ws + WS_H), *yo = (bf16*)(ws + WS_YO);
    float* wrt = (float*)(ws + WS_WRT); unsigned* ctl = (unsigned*)(ws + WS_CTL); int* misc = (int*)(ws + WS_MISC); int* hist = (int*)(ws + WS_MISC + 4096);
    int* tok_e = (int*)(ws + WS_TOK); int* tok_pos = tok_e + 2 * T; float* tok_gate = (float*)(tok_pos + 2 * T); int* tok_slot = (int*)(tok_gate + 2 * T);
    bf16* lora = (bf16*)(ws + WS_LORA); float* gcr = (float*)(ws + WS_GCR); float* dch = (float*)(ws + WS_DCH);
    for (int u = tid; u < (LDS_BYTES - LDSCTL_OFF) / 4; u += NTHR) ((LAS unsigned*)(lds + LDSCTL_OFF))[u] = 0u;
    __syncthreads();
    XcdBarrier bar; bar.bar = ctl + CW_BAR; bar.x = 0; bar.st = nullptr;
    const int lo = args.ph_lo, hi = args.ph_hi;
    if (hi - lo > 1) bar = xcd_barrier_post(ctl + CW_BAR, MISC + 8);
#define IN(k) (lo <= (k) && (k) < hi)
#define SEAM(k) do { if (IN(k) && IN((k) + 1)) xcd_barrier(bar); } while (0)
    LAS float* wscr = (LAS float*)(lds + wave * 16384);

#ifndef DUP_MASK
#define DUP_MASK 0
#endif
    unsigned long long tacc = 0;
#define PH0 do { ph_prep1(in[2], in[17], in[19], in[21], in[18], in[5], in[7], in[8], win_t, wout_t, wrt, lora, wscr, gw, NGW, lane); ph_rmsnorm(in[0], in[1], xn, gw, NGW, lane); } while (0)
#define PH1 do { pg8::Gemm g{D}; pg8::StaticOrder S; S.init(xn, win_t, T, DIN, D, G, blk); pg8::EpiBf16 E{p, DIN}; pg8::gemm_phase<pg8::EpiBf16, pg8::StaticOrder, true, true>(lds, g, S, E); } while (0)
#define PH2 do { { v4u rawv[4], curv[4], prvv[4]; if (blk < BATCH * 8 * NCH) rwkv_issue(blk, p, tid, rawv, curv, prvv); for (int u = blk; u < BATCH * 8 * NCH; u += G) rwkv_unitA(u, p, in[3], in[4], in[6], in[9], in[10], in[11], lora, lora + 512 * 64, lora + 2 * 512 * 64, ws + WS_IAR, gcr, lds, tid, tacc, rawv, curv, prvv, u + G < BATCH * 8 * NCH ? u + G : -1); } \
        { STAGE_T0(9); for (int u = blk; u < BATCH * 4 * NCH; u += G) hgrn_unitA(u, p, in[14], in[15], (unsigned char*)out, dch, xn, lds, tid); STAGE_T1(9); } } while (0)
#define PH3 do { if (blk < BATCH * 8) rwkv_seqB(blk, ws + WS_IAR, gcr, in[12], in[13], xn, lds, tid); \
        else if (blk < BATCH * 8 + BATCH * 4) hgrn_seqB(blk - BATCH * 8, (const unsigned char*)out, dch, in[16], xn, lds, tid, tacc); \
        else ph_prep2(in[23], in[24], in[25], wgu_t, wd_t, wscr, (blk - 96) * NWAVES + wave, (G - 96) * NWAVES, lane); } while (0)
#define PH4 do { } while (0)
#define PH5 do { pg8::Gemm g{D}; pg8::StaticOrder S; S.init(xn, wout_t, T, D, D, G, blk); pg8::EpiResF32 E{in[0], out, D}; pg8::gemm_phase<pg8::EpiResF32, pg8::StaticOrder, true, true>(lds, g, S, E); } while (0)
#define PH6 ph_router(out, in[18], wrt, in[20], in[22], xn, hist, tok_e, tok_pos, tok_gate, (LAS float*)lds, blk, G, wave, lane, tacc)
#define PH7 ph_scatter(xn, hist, tok_e, tok_pos, misc, xg, tok_slot, (LAS int*)lds, G, gw, NGW, lane, tid)
#define PH8 do { const int ntiles = __builtin_amdgcn_readfirstlane(misc[0]); pg8::Gemm g{D}; pg8::MoeOrder S; S.init(xg, wgu_t, misc + 64, ntiles, 1024, D, G, blk); pg8::EpiSwiGLU E{H, DE}; \
        pg8::gemm_phase<pg8::EpiSwiGLU, pg8::MoeOrder, true, true>(lds, g, S, E); } while (0)
#define PH9 do { const int ntiles = __builtin_amdgcn_readfirstlane(misc[0]); pg8::Gemm g{DE}; pg8::MoeOrder S; S.init(H, wd_t, misc + 64, ntiles, D, DE, G, blk); pg8::EpiBf16 E{yo, D}; \
        pg8::gemm_phase<pg8::EpiBf16, pg8::MoeOrder, true, true>(lds, g, S, E); } while (0)
#define PH10 ph_final(out, yo, tok_slot, tok_gate, in[26], gw, NGW, lane)
#define RUN(k, BODY) do { if (IN(k)) { BODY; if ((DUP_MASK >> (k)) & 1) { xcd_barrier(bar); BODY; } } } while (0)
    { STAGE_T0(13); RUN(0, PH0); STAGE_T1(13); } SEAM(0);
    { STAGE_T0(15); RUN(1, PH1); STAGE_T1(15); } SEAM(1);
    RUN(2, PH2);
    if (IN(2) && ((DUP_MASK >> 16) & 1)) { xcd_barrier(bar); { v4u rawv[4], curv[4], prvv[4]; if (blk < BATCH * 8 * NCH) rwkv_issue(blk, p, tid, rawv, curv, prvv); for (int u = blk; u < BATCH * 8 * NCH; u += G) rwkv_unitA(u, p, in[3], in[4], in[6], in[9], in[10], in[11], lora, lora + 512 * 64, lora + 2 * 512 * 64, ws + WS_IAR, gcr, lds, tid, tacc, rawv, curv, prvv, u + G < BATCH * 8 * NCH ? u + G : -1); } }
    if (IN(2) && ((DUP_MASK >> 17) & 1)) { xcd_barrier(bar); for (int u = blk; u < BATCH * 4 * NCH; u += G) hgrn_unitA(u, p, in[14], in[15], (unsigned char*)out, dch, xn, lds, tid); }
    SEAM(2);
    if (IN(3)) { STAGE_T0(22); PH3; STAGE_T1(22); if ((DUP_MASK >> 3) & 1) { xcd_barrier(bar); PH2; xcd_barrier(bar); PH3; } }
    if (IN(3) && IN(5)) xcd_barrier(bar);
    { STAGE_T0(16); RUN(5, PH5); STAGE_T1(16); } SEAM(5);
    if (IN(6)) { STAGE_T0(10); PH6; STAGE_T1(10); }
    SEAM(6);
    if (IN(7)) { STAGE_T0(11); PH7; STAGE_T1(11); }
    SEAM(7);
    { STAGE_T0(17); RUN(8, PH8); STAGE_T1(17); } SEAM(8);
    { STAGE_T0(18); RUN(9, PH9); STAGE_T1(18); } SEAM(9);
    if (IN(10)) { STAGE_T0(12); PH10; STAGE_T1(12); }
    if (PROBE_STAGE != 0 && blk == PROBE_BLK) { const unsigned long long te = __builtin_amdgcn_s_memrealtime(); while (__builtin_amdgcn_s_memrealtime() - te < PROBE_AMP * tacc) __builtin_amdgcn_s_sleep(8); }
#undef IN
#undef SEAM
}

extern "C" void kernel_launch(void* const* d_in, const int* in_sizes, int n_in, void* d_out, int out_size, void* d_ws, size_t ws_size, hipStream_t stream) {
    static int grid = 0;
    if (grid == 0) {
        if (n_in != 27 || in_sizes[0] != T * D || out_size != T * D || ws_size < WS_END) { fprintf(stderr, "kernel_launch: unexpected shapes (n_in %d, in0 %d, out %d, ws %zu)\n", n_in, n_in > 0 ? in_sizes[0] : -1, out_size, ws_size); grid = -1; return; }
        int dev = 0, cus = 0;
        if (hipGetDevice(&dev) != hipSuccess || hipDeviceGetAttribute(&cus, hipDeviceAttributeMultiprocessorCount, dev) != hipSuccess) { grid = -1; return; }
        if (hipFuncSetAttribute((const void*)mega_kernel, hipFuncAttributeMaxDynamicSharedMemorySize, LDS_BYTES) != hipSuccess) { fprintf(stderr, "kernel_launch: hipFuncSetAttribute failed\n"); grid = -1; return; }
        grid = cus;
    }
    if (grid < 0) return;
    if (hipMemsetAsync((char*)d_ws + WS_CTL, 0, CTL_ZERO_BYTES, stream) != hipSuccess) return;
    Args a{};
    for (int i = 0; i < 27; ++i) a.in[i] = (const float*)d_in[i];
    a.out = (float*)d_out; a.ws = (unsigned char*)d_ws;
    if (MK_N_LAUNCHES == 1) { a.ph_lo = 0; a.ph_hi = N_PHASES; hipLaunchKernelGGL(mega_kernel, dim3(grid), dim3(NTHR), LDS_BYTES, stream, a); }
    else for (int k = 0; k < N_PHASES; ++k) { a.ph_lo = k; a.ph_hi = k + 1; hipLaunchKernelGGL(mega_kernel, dim3(grid), dim3(NTHR), LDS_BYTES, stream, a); }
}
```
